# Optimizing an MI355X kernel written in HIP

```python
import math
import jax, jax.numpy as jnp
from jax import lax
import numpy as np

D_MODEL = 2048
BATCH = 4
SEQ = 2048
DEPTH = 2

HG_HEADS = 8
HG_KDIM = 128
HG_VDIM = 128
HG_WIDTH = HG_HEADS * HG_VDIM
HG_CHUNK = 64
POOL_WINDOWS = (2, 4, 8, 16)
POOL_GROUPS = len(POOL_WINDOWS)
POOL_WIDTH = 1024
POOL_GDIM = POOL_WIDTH // POOL_GROUPS
SG_GROUPS = 8
SG_WIDTH = 1024
SG_GDIM = SG_WIDTH // SG_GROUPS
SG_CHUNK = 128
N_BRANCH = 3
D_FF = 5632
CONV_W = 3
LN_EPS = 1e-5
RMS_EPS = 1e-6
DN_ALPHA = (2 * DEPTH) ** 0.25
DN_BETA = (8 * DEPTH) ** -0.25
IN_WIDTHS = (HG_HEADS * HG_KDIM, HG_HEADS * HG_KDIM, HG_WIDTH, HG_WIDTH,
             POOL_WIDTH, SG_WIDTH, SG_WIDTH, N_BRANCH * D_MODEL)
D_IN = sum(IN_WIDTHS)
IN_SPLITS = tuple(int(c) for c in np.cumsum(IN_WIDTHS)[:-1])

kernel_name = "hybrid_hgrn2_pool_sgu_deepnorm"


def layer_norm(x, g, b):
    xf = x.astype(jnp.float32)
    mu = jnp.mean(xf, axis=-1, keepdims=True)
    var = jnp.mean(jnp.square(xf - mu), axis=-1, keepdims=True)
    y = (xf - mu) * lax.rsqrt(var + LN_EPS) * g.astype(jnp.float32) + b.astype(jnp.float32)
    return y.astype(x.dtype)


def hgrn2_mixer(q, f_raw, v, og, lb, norm_g):
    B, S, _ = v.shape
    dt = v.dtype
    nc = S // HG_CHUNK
    f32 = jnp.float32
    lbf = lb.astype(f32)
    fr = f_raw.astype(f32)
    qf = jax.nn.silu(q.astype(f32))
    log_f = jnp.logaddexp(jnp.log(lbf), jnp.log1p(-lbf) + jax.nn.log_sigmoid(fr))
    kf = (1.0 - lbf) * jax.nn.sigmoid(-fr)
    vf = v.astype(f32)

    def to_chunks(t, d):
        return t.reshape(B, nc, HG_CHUNK, HG_HEADS, d).transpose(1, 0, 3, 2, 4)

    qc, kc, lfc = to_chunks(qf, HG_KDIM), to_chunks(kf, HG_KDIM), to_chunks(log_f, HG_KDIM)
    vc = to_chunks(vf, HG_VDIM)
    causal = jnp.tril(jnp.ones((HG_CHUNK, HG_CHUNK), dtype=bool))

    def step(state, inp):
        q_c, k_c, lf_c, v_c = inp
        b = jnp.cumsum(lf_c, axis=2)
        b_last = b[:, :, -1:, :]
        o_inter = jnp.einsum('bhck,bhkv->bhcv', q_c * jnp.exp(b), state)
        diff = b[:, :, :, None, :] - b[:, :, None, :, :]
        decay = jnp.exp(jnp.where(causal[:, :, None], diff, -jnp.inf))
        scores = jnp.einsum('bhtk,bhtsk,bhsk->bhts', q_c, decay, k_c)
        o = o_inter + jnp.einsum('bhts,bhsv->bhtv', scores, v_c)
        new_state = (jnp.exp(b_last[:, :, 0, :])[..., None] * state
                     + jnp.einsum('bhsk,bhsv->bhkv', k_c * jnp.exp(b_last - b), v_c))
        return new_state, o

    s0 = jnp.zeros((B, HG_HEADS, HG_KDIM, HG_VDIM), f32)
    _, o = lax.scan(step, s0, (qc, kc, lfc, vc))
    o = o.transpose(1, 0, 3, 2, 4).reshape(B, S, HG_HEADS, HG_VDIM)
    o = o * lax.rsqrt(jnp.mean(jnp.square(o), axis=-1, keepdims=True) + RMS_EPS)
    o = o.reshape(B, S, HG_WIDTH) * norm_g.astype(f32) * jax.nn.silu(og.astype(f32))
    return o.astype(dt)


def pool_mixer(p, w_grp, scale):
    B, S, _ = p.shape
    dt = p.dtype
    pf = p.astype(jnp.float32).reshape(B, S, POOL_GROUPS, POOL_GDIM)
    cs = jnp.cumsum(pf, axis=1)
    count_base = jnp.arange(1, S + 1, dtype=jnp.float32)
    outs = []
    for g, w in enumerate(POOL_WINDOWS):
        c = cs[:, :, g]
        lagged = jnp.pad(c, ((0, 0), (w, 0), (0, 0)))[:, :S]
        mean = (c - lagged) / jnp.minimum(count_base, float(w))[None, :, None]
        outs.append(mean - pf[:, :, g])
    pooled = jnp.stack(outs, axis=2)
    y = jnp.einsum('bsgc,gcd->bsgd', pooled, w_grp.astype(jnp.float32)).reshape(B, S, POOL_WIDTH)
    return (y * scale.astype(jnp.float32)).astype(dt)


def sgu_mixer(u, v, ln_g, ln_b, w_s, b_s):
    B, S, _ = u.shape
    u = jax.nn.gelu(u)
    v = layer_norm(jax.nn.gelu(v), ln_g, ln_b)
    nc = S // SG_CHUNK
    vc = v.reshape(B, nc, SG_CHUNK, SG_GROUPS, SG_GDIM)
    w = w_s * jnp.tril(jnp.ones((SG_CHUNK, SG_CHUNK), dtype=w_s.dtype))
    mixed = jnp.einsum('gts,bnsgd->bntgd', w, vc) + b_s.T[None, None, :, :, None]
    return u * mixed.reshape(B, S, SG_WIDTH)


def conv_ffn(x, w_up, conv_w, conv_b, w_down):
    h = x @ w_up
    S = h.shape[1]
    hp = jnp.pad(h, ((0, 0), (CONV_W - 1, 0), (0, 0)))
    acc = conv_b + conv_w[0] * hp[:, 0:S]
    for j in range(1, CONV_W):
        acc = acc + conv_w[j] * hp[:, j:j + S]
    a, b = jnp.split(acc, 2, axis=-1)
    return (jax.nn.silu(a) * b) @ w_down


def setup_inputs(seed: int = 0) -> dict:
    key = jax.random.key(seed)
    ks = jax.random.split(key, 24)
    L = DEPTH

    def nrm(k, shape, scale):
        return jax.random.normal(k, shape, jnp.float32) * scale

    return {
        "x": nrm(ks[0], (BATCH, SEQ, D_MODEL), 1.0),
        "w_in": nrm(ks[1], (L, D_MODEL, D_IN), D_MODEL ** -0.5),
        "hg_lower_bounds": nrm(ks[2], (L, HG_HEADS * HG_KDIM), 0.1),
        "hg_norm_g": 1.0 + nrm(ks[3], (L, HG_WIDTH), 0.02),
        "pool_w": nrm(ks[4], (L, POOL_GROUPS, POOL_GDIM, POOL_GDIM), POOL_GDIM ** -0.5),
        "pool_scale": 1.0 + nrm(ks[5], (L, POOL_WIDTH), 0.02),
        "sg_ln_g": 1.0 + nrm(ks[6], (L, SG_WIDTH), 0.02),
        "sg_ln_b": nrm(ks[7], (L, SG_WIDTH), 0.02),
        "sg_w": nrm(ks[8], (L, SG_GROUPS, SG_CHUNK, SG_CHUNK), 0.5 * SG_CHUNK ** -0.5),
        "sg_b": 1.0 + nrm(ks[9], (L, SG_GROUPS, SG_CHUNK), 0.02),
        "w_hg_proj": nrm(ks[10], (L, HG_WIDTH, D_MODEL), DN_BETA * HG_WIDTH ** -0.5),
        "w_pool_proj": nrm(ks[11], (L, POOL_WIDTH, D_MODEL), DN_BETA * POOL_WIDTH ** -0.5),
        "w_sg_proj": nrm(ks[12], (L, SG_WIDTH, D_MODEL), DN_BETA * SG_WIDTH ** -0.5),
        "w_out": nrm(ks[13], (L, D_MODEL, D_MODEL), DN_BETA * D_MODEL ** -0.5),
        "ln1_g": 1.0 + nrm(ks[14], (L, D_MODEL), 0.02),
        "ln1_b": nrm(ks[15], (L, D_MODEL), 0.02),
        "w_up": nrm(ks[16], (L, D_MODEL, 2 * D_FF), DN_BETA * D_MODEL ** -0.5),
        "conv_w": nrm(ks[17], (L, CONV_W, 2 * D_FF), CONV_W ** -0.5),
        "conv_b": nrm(ks[18], (L, 2 * D_FF), 0.02),
        "w_down": nrm(ks[19], (L, D_FF, D_MODEL), DN_BETA * D_FF ** -0.5),
        "ln2_g": 1.0 + nrm(ks[20], (L, D_MODEL), 0.02),
        "ln2_b": nrm(ks[21], (L, D_MODEL), 0.02),
    }


def reference(x, w_in, hg_lower_bounds, hg_norm_g, pool_w, pool_scale, sg_ln_g, sg_ln_b,
              sg_w, sg_b, w_hg_proj, w_pool_proj, w_sg_proj, w_out, ln1_g, ln1_b,
              w_up, conv_w, conv_b, w_down, ln2_g, ln2_b):
    B, S, D = x.shape
    lb_all = jnp.cumsum(jax.nn.softmax(hg_lower_bounds.astype(jnp.float32), axis=0), axis=0)
    lb_all = lb_all - lb_all[0:1]
    for l in range(DEPTH):
        z = x @ w_in[l]
        q, f_raw, i_in, og, p, u, v, gr = jnp.split(z, IN_SPLITS, axis=-1)
        y_hg = hgrn2_mixer(q, f_raw, i_in, og, lb_all[l], hg_norm_g[l])
        y_pool = pool_mixer(p, pool_w[l], pool_scale[l])
        y_sg = sgu_mixer(u, v, sg_ln_g[l], sg_ln_b[l], sg_w[l], sg_b[l])
        gates = jax.nn.sigmoid(gr.astype(jnp.float32)).astype(x.dtype).reshape(B, S, N_BRANCH, D)
        merged = (gates[:, :, 0] * (y_hg @ w_hg_proj[l])
                  + gates[:, :, 1] * (y_pool @ w_pool_proj[l])
                  + gates[:, :, 2] * (y_sg @ w_sg_proj[l]))
        mix = merged @ w_out[l]
        x = layer_norm(DN_ALPHA * x + mix, ln1_g[l], ln1_b[l])
        x = layer_norm(DN_ALPHA * x + conv_ffn(x, w_up[l], conv_w[l], conv_b[l], w_down[l]),
                       ln2_g[l], ln2_b[l])
    return x
```

```cpp
#include <hip/hip_runtime.h>
#include <hip/hip_cooperative_groups.h>
#include <cstdio>
#include <cstdint>
namespace cg = cooperative_groups;
namespace pg8 {
#define PG8_LAS __attribute__((address_space(3)))
typedef unsigned short bf16_t;
typedef short bf16x8 __attribute__((ext_vector_type(8)));
typedef float f32x4 __attribute__((ext_vector_type(4)));
typedef unsigned u32x4 __attribute__((ext_vector_type(4)));
constexpr int BM = 256, BK = 64, HALF = 128, HTB = HALF * BK * 2  , STAGE_BYTES = 8 * HTB, NXCD = 8, WGM = 8;

__host__ __device__ __forceinline__ int lds_byte(int r, int c) { const int st = (r >> 4) * 2 + (c >> 5), rr = r & 15, cc = c & 31, ob = rr * 64 + cc * 2; return st * 1024 + (ob ^ (((ob >> 9) & 1) << 5)); }
__host__ __device__ __forceinline__ void stage_rc(int b, int& R, int& C) { const int st = b / 1024, sb = b % 1024, swz = sb ^ (((sb >> 9) & 1) << 5); R = (st >> 1) * 16 + swz / 64; C = (st & 1) * 32 + (swz % 64) / 2; }
__host__ __device__ __forceinline__ int perm32(int rho) { const int n = rho >> 4, i = rho & 15; return 8 * (i >> 2) + 4 * n + (i & 3); }

struct Unit { int pm, pn; };
struct Gemm { const bf16_t* A; const bf16_t* Bt; int M, N, K; };

struct StaticOrder {
    int nM, nN, nwg, G, c;
    __host__ __device__ void init(int M, int N, int G_, int c_) { nM = M / BM; nN = N / BM; nwg = nM * nN; G = G_; c = c_; }
    __host__ __device__ bool next(int i, Unit& u) const {
        const long L = (long)i * G + c; if (L >= nwg) return false;
        int wgid = (int)L; { const int q = nwg / NXCD, r = nwg % NXCD, xcd = wgid % NXCD, off = wgid / NXCD; wgid = (xcd < r ? xcd * (q + 1) : r * (q + 1) + (xcd - r) * q) + off; }
        const int nig = WGM * nN, gid = wgid / nig, fm = gid * WGM, gsz = (nM - fm) < WGM ? (nM - fm) : WGM;
        u.pm = fm + ((wgid % nig) % gsz); u.pn = (wgid % nig) / gsz; return true;
    }
    __device__ __forceinline__ void a_ready(const Unit&) const {}
    __device__ __forceinline__ void done(const Unit&) const {}
};
__device__ __forceinline__ unsigned cvt_pk_bf16(float lo, float hi) { unsigned r; asm volatile("v_cvt_pk_bf16_f32 %0, %1, %2" : "=v"(r) : "v"(lo), "v"(hi)); return r; }
typedef float f32x2 __attribute__((ext_vector_type(2)));
__device__ __forceinline__ float bf_lo(unsigned w) { return __uint_as_float(w << 16); }
__device__ __forceinline__ float bf_hi(unsigned w) { return __uint_as_float(w & 0xffff0000u); }
__device__ __forceinline__ float sigm(float t) { return __builtin_amdgcn_rcpf(1.0f + __expf(-t)); }

struct EpiIn {
    static constexpr bool PERM = true, AFTER_DRAIN = false;
    bf16_t* Z; float* LF; const float* lb;
    __device__ __forceinline__ void operator()(const f32x4 (&acc)[2][2][4][2], const Unit& u, int wr, int wc, int fr, int fq) const {
        const int sec = u.pn >> 2;
        const int row0 = u.pm * BM + wr * 64 + fr, col0 = u.pn * BM + wc * 32 + 8 * fq;
        if (sec == 1) {
#pragma unroll
            for (int bj = 0; bj < 2; ++bj) {
                const int kc = col0 + bj * HALF - 1024;
                const f32x4 l0 = *(const f32x4*)(lb + kc), l1 = *(const f32x4*)(lb + kc + 4);
#pragma unroll
                for (int ai = 0; ai < 2; ++ai)
#pragma unroll
                    for (int m = 0; m < 4; ++m) {
                        const size_t row = (size_t)(row0 + ai * HALF + m * 16);
                        f32x4 lf0, lf1, k0, k1;
#pragma unroll
                        for (int j = 0; j < 4; ++j) {
                            { float x = fminf(fmaxf(acc[ai][bj][m][0][j], -80.f), 80.f); const float e = __expf(-x), s = __builtin_amdgcn_rcpf(1.0f + e), sm = e * s, l = l0[j];
                              lf0[j] = __logf(l + (1.0f - l) * s); k0[j] = (1.0f - l) * sm; }
                            { float x = fminf(fmaxf(acc[ai][bj][m][1][j], -80.f), 80.f); const float e = __expf(-x), s = __builtin_amdgcn_rcpf(1.0f + e), sm = e * s, l = l1[j];
                              lf1[j] = __logf(l + (1.0f - l) * s); k1[j] = (1.0f - l) * sm; }
                        }
                        *(f32x4*)(LF + row * 1024 + kc) = lf0; *(f32x4*)(LF + row * 1024 + kc + 4) = lf1;
                        u32x4 w; w.x = cvt_pk_bf16(k0[0], k0[1]); w.y = cvt_pk_bf16(k0[2], k0[3]); w.z = cvt_pk_bf16(k1[0], k1[1]); w.w = cvt_pk_bf16(k1[2], k1[3]);
                        *(u32x4*)(Z + row * 13312 + col0 + bj * HALF) = w;
                    }
            }
        } else {
            float c1 = 1.0f, c3 = 0.0f; bool fx = true, fs = true;
            if (sec == 2 || sec == 4) fs = false;
            else if (sec == 5 || sec == 6) { c1 = 1.5957691216057308f; c3 = 0.044715f; }
            else if (sec >= 7) fx = false;
#pragma unroll
            for (int ai = 0; ai < 2; ++ai)
#pragma unroll
                for (int m = 0; m < 4; ++m) {
                    const size_t row = (size_t)(row0 + ai * HALF + m * 16);
#pragma unroll
                    for (int bj = 0; bj < 2; ++bj) {
                        f32x4 v0 = acc[ai][bj][m][0], v1 = acc[ai][bj][m][1];
                        if (fs) {
#pragma unroll
                            for (int j = 0; j < 4; ++j) {
                                { const float x = v0[j], s = sigm(c1 * x * (1.0f + c3 * x * x)); v0[j] = fx ? x * s : s; }
                                { const float x = v1[j], s = sigm(c1 * x * (1.0f + c3 * x * x)); v1[j] = fx ? x * s : s; }
                            }
                        }
                        u32x4 w; w.x = cvt_pk_bf16(v0[0], v0[1]); w.y = cvt_pk_bf16(v0[2], v0[3]); w.z = cvt_pk_bf16(v1[0], v1[1]); w.w = cvt_pk_bf16(v1[2], v1[3]);
                        *(u32x4*)(Z + row * 13312 + col0 + bj * HALF) = w;
                    }
                }
        }
    }
};

struct EpiStore {
    static constexpr bool PERM = true, AFTER_DRAIN = false;
    bf16_t* O; int ldc;
    __device__ __forceinline__ void operator()(const f32x4 (&acc)[2][2][4][2], const Unit& u, int wr, int wc, int fr, int fq) const {
        const int row0 = u.pm * BM + wr * 64 + fr, col0 = u.pn * BM + wc * 32 + 8 * fq;
#pragma unroll
        for (int ai = 0; ai < 2; ++ai)
#pragma unroll
            for (int m = 0; m < 4; ++m) {
                bf16_t* rowp = O + (size_t)(row0 + ai * HALF + m * 16) * ldc + col0;
#pragma unroll
                for (int bj = 0; bj < 2; ++bj) {
                    const f32x4 v0 = acc[ai][bj][m][0], v1 = acc[ai][bj][m][1];
                    u32x4 w; w.x = cvt_pk_bf16(v0[0], v0[1]); w.y = cvt_pk_bf16(v0[2], v0[3]); w.z = cvt_pk_bf16(v1[0], v1[1]); w.w = cvt_pk_bf16(v1[2], v1[3]);
                    *(u32x4*)(rowp + bj * HALF) = w;
                }
            }
    }
};

template <int MODE> struct EpiGate {
    static constexpr bool PERM = true, AFTER_DRAIN = false;
    const bf16_t* G; float* TMP; bf16_t* MG;
    __device__ __forceinline__ void operator()(const f32x4 (&acc)[2][2][4][2], const Unit& u, int wr, int wc, int fr, int fq) const {
        const int row0 = u.pm * BM + wr * 64 + fr, col0 = u.pn * BM + wc * 32 + 8 * fq;
#pragma unroll
        for (int ai = 0; ai < 2; ++ai)
#pragma unroll
            for (int m = 0; m < 4; ++m) {
                const size_t row = (size_t)(row0 + ai * HALF + m * 16);
#pragma unroll
                for (int bj = 0; bj < 2; ++bj) {
                    const int col = col0 + bj * HALF;
                    const u32x4 gw = *(const u32x4*)(G + row * 13312 + col);
                    f32x4 g0 = {bf_lo(gw.x), bf_hi(gw.x), bf_lo(gw.y), bf_hi(gw.y)}, g1 = {bf_lo(gw.z), bf_hi(gw.z), bf_lo(gw.w), bf_hi(gw.w)};
                    f32x4 v0 = acc[ai][bj][m][0] * g0, v1 = acc[ai][bj][m][1] * g1;
                    float* tp = TMP + row * 2048 + col;
                    if (MODE >= 1) { v0 += *(const f32x4*)tp; v1 += *(const f32x4*)(tp + 4); }
                    if (MODE <= 1) { *(f32x4*)tp = v0; *(f32x4*)(tp + 4) = v1; }
                    else { u32x4 w; w.x = cvt_pk_bf16(v0[0], v0[1]); w.y = cvt_pk_bf16(v0[2], v0[3]); w.z = cvt_pk_bf16(v1[0], v1[1]); w.w = cvt_pk_bf16(v1[2], v1[3]);
                        *(u32x4*)(MG + row * 2048 + col) = w; }
                }
            }
    }
};

struct EpiRes {
    static constexpr bool PERM = true, AFTER_DRAIN = false;
    const float* R; float* T; float alpha;
    __device__ __forceinline__ void operator()(const f32x4 (&acc)[2][2][4][2], const Unit& u, int wr, int wc, int fr, int fq) const {
        const int row0 = u.pm * BM + wr * 64 + fr, col0 = u.pn * BM + wc * 32 + 8 * fq;
#pragma unroll
        for (int ai = 0; ai < 2; ++ai)
#pragma unroll
            for (int m = 0; m < 4; ++m) {
                const size_t row = (size_t)(row0 + ai * HALF + m * 16);
#pragma unroll
                for (int bj = 0; bj < 2; ++bj) {
                    const size_t o = row * 2048 + col0 + bj * HALF;
                    const f32x4 r0 = *(const f32x4*)(R + o), r1 = *(const f32x4*)(R + o + 4);
                    *(f32x4*)(T + o) = r0 * alpha + acc[ai][bj][m][0]; *(f32x4*)(T + o + 4) = r1 * alpha + acc[ai][bj][m][1];
                }
            }
    }
};
template <class Epi, class Sched, bool ALIGN_EPI = false, bool SP2 = false>
__device__ __forceinline__ void gemm_phase(PG8_LAS unsigned char* lds, const Gemm g, const Sched& S, const Epi& E) {
    int tid_o = threadIdx.x; asm volatile("" : "+v"(tid_o));
    const int tid = tid_o, wid = __builtin_amdgcn_readfirstlane(tid >> 6), lane = tid & 63, wr = wid >> 2, wc = wid & 3, fr = lane & 15, fq = lane >> 4;
    const int K = g.K, nt = K / BK;
    unsigned voffA[2], voffB[2];
#pragma unroll
    for (int i = 0; i < 2; ++i) { int R, C; stage_rc(tid * 16 + i * 8192, R, C); const int Rb = Epi::PERM ? ((R & ~31) + perm32(R & 31)) : R;
        voffA[i] = (unsigned)(R * K + C) * 2u; voffB[i] = (unsigned)(Rb * K + C) * 2u; }
    const size_t kstep = (size_t)(BK * 2);
    const size_t hstep = (size_t)HALF * K * 2;
    const size_t tstep = 2 * hstep;
    const unsigned ldsw = (unsigned)wid * 1024u;
    const int aoff = lds_byte(wr * 64 + fr, fq * 8), boff = lds_byte(wc * 32 + fr, fq * 8);
#define PG8_SA(b, h) (((b) * 2 + (h)) * HTB)
#define PG8_SB(b, h) ((4 + (b) * 2 + (h)) * HTB)
#define PG8_STAGE(bufoff, gbase, voff) do { _Pragma("unroll") for (int _i = 0; _i < 2; ++_i) \
        __builtin_amdgcn_global_load_lds((const unsigned*)((const char*)(gbase) + (voff)[_i]), (PG8_LAS unsigned*)(lds + (bufoff) + ldsw + _i * 8192), 16, 0, 0); } while (0)
#define PG8_LDA(dst, b, h) do { _Pragma("unroll") for (int m = 0; m < 4; ++m) _Pragma("unroll") for (int k = 0; k < 2; ++k) dst[m][k] = *(const PG8_LAS bf16x8*)(lds + PG8_SA(b, h) + aoff + m * 2048 + k * 1024); } while (0)
#define PG8_LDB(dst, b, h) do { _Pragma("unroll") for (int n = 0; n < 2; ++n) _Pragma("unroll") for (int k = 0; k < 2; ++k) dst[n][k] = *(const PG8_LAS bf16x8*)(lds + PG8_SB(b, h) + boff + n * 2048 + k * 1024); } while (0)
#define PG8_MMA(ai, bj, At, Bt) do { __builtin_amdgcn_s_setprio(1); _Pragma("unroll") for (int m = 0; m < 4; ++m) _Pragma("unroll") for (int n = 0; n < 2; ++n) _Pragma("unroll") for (int k = 0; k < 2; ++k) \
        acc[ai][bj][m][n] = __builtin_amdgcn_mfma_f32_16x16x32_bf16(Bt[n][k], At[m][k], acc[ai][bj][m][n], 0, 0, 0); __builtin_amdgcn_s_setprio(0); } while (0)
#define PG8_WAIT_V(n) asm volatile("s_waitcnt vmcnt(" #n ")" ::: "memory")
#define PG8_WAIT_L(n) asm volatile("s_waitcnt lgkmcnt(" #n ")" ::: "memory")
#define PG8_BAR __builtin_amdgcn_s_barrier()
#define PG8_SCHED __builtin_amdgcn_sched_barrier(0)
    Unit cur, nxt; int ui = 0;
    if (!S.next(0, cur)) return;
    f32x4 acc[2][2][4][2];
#pragma unroll
    for (int a = 0; a < 2; ++a)
#pragma unroll
        for (int b = 0; b < 2; ++b)
#pragma unroll
            for (int m = 0; m < 4; ++m)
#pragma unroll
                for (int n = 0; n < 2; ++n) acc[a][b][m][n] = (f32x4){0.f, 0.f, 0.f, 0.f};
    bf16x8 At[4][2], B0[2][2], B1[2][2];
    const char* cA = (const char*)g.A + (size_t)cur.pm * tstep; const char* cB = (const char*)g.Bt + (size_t)cur.pn * tstep;
    S.a_ready(cur);
    if constexpr (SP2) {
        PG8_STAGE(PG8_SB(0, 0), cB, voffB); PG8_STAGE(PG8_SB(0, 1), cB + hstep, voffB); PG8_STAGE(PG8_SA(0, 0), cA, voffA); PG8_STAGE(PG8_SA(0, 1), cA + hstep, voffA);
        if (wr == 1) PG8_BAR;
        PG8_WAIT_V(2); PG8_BAR;
        PG8_STAGE(PG8_SB(1, 0), cB + kstep, voffB); PG8_STAGE(PG8_SA(1, 0), cA + kstep, voffA); PG8_STAGE(PG8_SB(1, 1), cB + hstep + kstep, voffB);
        PG8_WAIT_V(6); PG8_BAR;
    } else {
        PG8_STAGE(PG8_SB(0, 0), cB, voffB); PG8_STAGE(PG8_SA(0, 0), cA, voffA); PG8_STAGE(PG8_SB(0, 1), cB + hstep, voffB); PG8_STAGE(PG8_SA(0, 1), cA + hstep, voffA);
        if (wr == 1) PG8_BAR;
        PG8_WAIT_V(4); PG8_BAR;
        PG8_STAGE(PG8_SB(1, 0), cB + kstep, voffB); PG8_STAGE(PG8_SA(1, 0), cA + kstep, voffA); PG8_STAGE(PG8_SB(1, 1), cB + hstep + kstep, voffB);
        PG8_WAIT_V(6); PG8_BAR;
    }
    for (;;) {
        const bool has_next = S.next(ui + 1, nxt);
        const char* nA = has_next ? (const char*)g.A + (size_t)nxt.pm * tstep : cA; const char* nB = has_next ? (const char*)g.Bt + (size_t)nxt.pn * tstep : cB;
        for (int t = 0; t < nt; t += 2) {
            const bool last = (t == nt - 2);
            const char* a1 = cA + (size_t)(t + 1) * kstep;
            const char* a2 = last ? nA : cA + (size_t)(t + 2) * kstep; const char* b2 = last ? nB : cB + (size_t)(t + 2) * kstep;
            const char* a3 = a2 + kstep; const char* b3 = b2 + kstep;
            if (last && has_next) S.a_ready(nxt);
            if constexpr (SP2) {
            PG8_LDB(B0, 0, 0); PG8_LDB(B1, 0, 1); PG8_SCHED; PG8_LDA(At, 0, 0); PG8_STAGE(PG8_SA(1, 1), a1 + hstep, voffA);
            PG8_WAIT_V(8); PG8_WAIT_L(0); PG8_BAR; PG8_MMA(0, 0, At, B0); PG8_MMA(0, 1, At, B1); PG8_BAR; PG8_SCHED;
            PG8_LDA(At, 0, 1); PG8_STAGE(PG8_SB(0, 0), b2, voffB); PG8_STAGE(PG8_SB(0, 1), b2 + hstep, voffB); PG8_STAGE(PG8_SA(0, 0), a2, voffA);
            PG8_WAIT_V(8); PG8_WAIT_L(0); PG8_BAR; PG8_MMA(1, 0, At, B0); PG8_MMA(1, 1, At, B1); PG8_BAR; PG8_SCHED;
            PG8_LDB(B0, 1, 0); PG8_LDB(B1, 1, 1); PG8_SCHED; PG8_LDA(At, 1, 0); PG8_STAGE(PG8_SA(0, 1), a2 + hstep, voffA);
            PG8_WAIT_V(8); PG8_WAIT_L(0); PG8_BAR; PG8_MMA(0, 0, At, B0); PG8_MMA(0, 1, At, B1); PG8_BAR; PG8_SCHED;
            PG8_LDA(At, 1, 1); PG8_STAGE(PG8_SB(1, 0), b3, voffB); PG8_STAGE(PG8_SB(1, 1), b3 + hstep, voffB); PG8_STAGE(PG8_SA(1, 0), a3, voffA);
            PG8_WAIT_V(8); PG8_WAIT_L(0); PG8_BAR; PG8_MMA(1, 0, At, B0); PG8_MMA(1, 1, At, B1); PG8_BAR; PG8_SCHED;
            } else {
            PG8_LDB(B0, 0, 0); PG8_SCHED; PG8_LDA(At, 0, 0); PG8_STAGE(PG8_SA(1, 1), a1 + hstep, voffA);
            PG8_WAIT_L(8); PG8_BAR; PG8_WAIT_L(0); PG8_MMA(0, 0, At, B0); PG8_BAR; PG8_SCHED;
            PG8_LDB(B1, 0, 1); PG8_STAGE(PG8_SB(0, 0), b2, voffB);
            PG8_BAR; PG8_WAIT_L(0); PG8_MMA(0, 1, At, B1); PG8_BAR;
            PG8_LDA(At, 0, 1); PG8_STAGE(PG8_SA(0, 0), a2, voffA);
            PG8_BAR; PG8_WAIT_L(0); PG8_MMA(1, 0, At, B0); PG8_BAR; PG8_SCHED;
            PG8_STAGE(PG8_SB(0, 1), b2 + hstep, voffB);
            PG8_WAIT_V(6); PG8_BAR; PG8_MMA(1, 1, At, B1); PG8_BAR;
            PG8_LDB(B0, 1, 0); PG8_SCHED; PG8_LDA(At, 1, 0); PG8_STAGE(PG8_SA(0, 1), a2 + hstep, voffA);
            PG8_WAIT_L(8); PG8_BAR; PG8_WAIT_L(0); PG8_MMA(0, 0, At, B0); PG8_BAR; PG8_SCHED;
            PG8_LDB(B1, 1, 1); PG8_STAGE(PG8_SB(1, 0), b3, voffB);
            PG8_BAR; PG8_WAIT_L(0); PG8_MMA(0, 1, At, B1); PG8_BAR;
            PG8_LDA(At, 1, 1); PG8_STAGE(PG8_SA(1, 0), a3, voffA);
            PG8_BAR; PG8_WAIT_L(0); PG8_MMA(1, 0, At, B0); PG8_BAR; PG8_SCHED;
            PG8_STAGE(PG8_SB(1, 1), b3 + hstep, voffB);
            PG8_WAIT_V(6); PG8_BAR; PG8_MMA(1, 1, At, B1); PG8_BAR;
            }
        }
        if constexpr (ALIGN_EPI) { if (wr == 0) PG8_BAR; }
        if constexpr (!Epi::AFTER_DRAIN) { E(acc, cur, wr, wc, fr, fq); S.done(cur); }
        if (!has_next) break;
#pragma unroll
        for (int a = 0; a < 2; ++a)
#pragma unroll
            for (int b = 0; b < 2; ++b)
#pragma unroll
                for (int m = 0; m < 4; ++m)
#pragma unroll
                    for (int n = 0; n < 2; ++n) acc[a][b][m][n] = (f32x4){0.f, 0.f, 0.f, 0.f};
        cur = nxt; cA = nA; cB = nB; ++ui;
        if constexpr (ALIGN_EPI) { if (wr == 1) PG8_BAR; }
    }
    PG8_WAIT_V(0);
    if constexpr (!ALIGN_EPI) { if (wr == 0) PG8_BAR; }
    PG8_BAR;
    if constexpr (Epi::AFTER_DRAIN) { E.fused(acc, cur, wr, wc, fr, fq, lds, wid, lane); S.done(cur); }
#undef PG8_SA
#undef PG8_SB
#undef PG8_STAGE
#undef PG8_LDA
#undef PG8_LDB
#undef PG8_MMA
#undef PG8_WAIT_V
#undef PG8_WAIT_L
#undef PG8_BAR
#undef PG8_SCHED
}
}

constexpr int BATCH = 4, SEQ = 2048, D = 2048, M = BATCH * SEQ, DIN = 13312, WID = 1024, DFF = 5632, DFF2 = 11264, DEPTH = 2;
constexpr int ZQ = 0, ZK = 1024, ZV = 2048, ZOG = 3072, ZP = 4096, ZU = 5120, ZSV = 6144, ZG = 7168;
constexpr float LN_EPS = 1e-5f, RMS_EPS = 1e-6f, DN_ALPHA = 1.4142135623730951f;
constexpr int NWAVES = 8, NT = 512;
constexpr size_t MiB = 1u << 20;
constexpr size_t WS_LB = 0, WS_STAT = 64 * 1024, WS_DEC = 1 * MiB;
constexpr size_t WS_W = 2 * MiB, W_IN = 0, W_UP = 52 * MiB, W_DOWN = 96 * MiB, W_OUT = 118 * MiB, W_P = 126 * MiB, W_PW = 138 * MiB, W_SGW = 138 * MiB + 512 * 1024;
constexpr size_t WS_XB = 142 * MiB, WS_Z = 174 * MiB, WS_MIX = 382 * MiB, WS_Y = 510 * MiB, WS_MG = 558 * MiB, WS_T = 590 * MiB, WS_X1F = 654 * MiB, WS_X1B = 718 * MiB, WS_END = 750 * MiB;
constexpr size_t MIX_LF = 0, MIX_UT = 32 * MiB, MIX_ST = 96 * MiB, MIX_G = 0, MIX_TMP = 32 * MiB;
constexpr int LDS_BYTES = 147456;

#define LAS __attribute__((address_space(3)))
typedef unsigned short bf16;
typedef short bf16x8 __attribute__((ext_vector_type(8)));
typedef float f32x4 __attribute__((ext_vector_type(4)));
typedef unsigned u32x4 __attribute__((ext_vector_type(4)));
typedef unsigned u32x2 __attribute__((ext_vector_type(2)));

__device__ __forceinline__ float bf2f(bf16 b) { return __uint_as_float(((unsigned)b) << 16); }
__device__ __forceinline__ unsigned f2bf(float f) { unsigned u = __float_as_uint(f); return (u + 0x7fffu + ((u >> 16) & 1u)) >> 16; }
__device__ __forceinline__ unsigned pk2(float lo, float hi) { return pg8::cvt_pk_bf16(lo, hi); }
__device__ __forceinline__ float blo(unsigned w) { return __uint_as_float(w << 16); }
__device__ __forceinline__ float bhi(unsigned w) { return __uint_as_float(w & 0xffff0000u); }
__device__ __forceinline__ float wave_sum(float v) {
#pragma unroll
    for (int o = 1; o < 64; o <<= 1) v += __shfl_xor(v, o);
    return v;
}
__device__ __forceinline__ bf16x8 lfrag(const LAS bf16* base, int pitch, int row0, int k0, int lane) {
    return *(const LAS bf16x8*)(base + (row0 + (lane & 15)) * pitch + k0 + 8 * (lane >> 4));
}
__device__ __forceinline__ bf16x8 gfrag(const bf16* base, int pitch, int row0, int k0, int lane) {
    return *(const bf16x8*)(base + (size_t)(row0 + (lane & 15)) * pitch + k0 + 8 * (lane >> 4));
}
#define MMA(a, b, c) __builtin_amdgcn_mfma_f32_16x16x32_bf16((a), (b), (c), 0, 0, 0)

__device__ __forceinline__ void transpose_item(const float* W, int K, int N, bf16* WT, LAS float* scr, int item, int lane) {
    const int nblk = N / 32, kb = item / nblk, nb = item % nblk, k0 = 64 * kb, n0 = 32 * nb;
#pragma unroll 8
    for (int i = 0; i < 32; ++i) { const int kk = 2 * i + (lane >> 5); scr[kk * 33 + (lane & 31)] = W[(size_t)(k0 + kk) * N + n0 + (lane & 31)]; }
    asm volatile("s_waitcnt lgkmcnt(0)" ::: "memory");
    const int c = lane & 7;
#pragma unroll
    for (int j = 0; j < 4; ++j) { const int n = (lane >> 3) + 8 * j; const LAS float* s = scr + (8 * c) * 33 + n;
        u32x4 o; o.x = pk2(s[0 * 33], s[1 * 33]); o.y = pk2(s[2 * 33], s[3 * 33]); o.z = pk2(s[4 * 33], s[5 * 33]); o.w = pk2(s[6 * 33], s[7 * 33]);
        *(u32x4*)(WT + (size_t)(n0 + n) * K + k0 + 8 * c) = o; }
    asm volatile("s_waitcnt lgkmcnt(0)" ::: "memory");
}

struct Args { const float* in[22]; float* out; unsigned char* ws; int ph_lo, ph_hi; };

__device__ __forceinline__ void prep_weights(const Args& a, int l, LAS unsigned char* lds, int tid, int lane, int wave) {
    unsigned char* wsw = a.ws + WS_W;
    LAS float* scr = (LAS float*)(lds + wave * 16384);
    const int gw = blockIdx.x * NWAVES + wave, NGW = gridDim.x * NWAVES;
    constexpr int I_IN = (D / 64) * (DIN / 32), I_UP = (D / 64) * (DFF2 / 32), I_DN = (DFF / 64) * (D / 32), I_OUT = (D / 64) * (D / 32), I_P = (WID / 64) * (D / 32), I_PW = (256 / 64) * (256 / 32);
    constexpr int NITEMS = I_IN + I_UP + I_DN + I_OUT + 3 * I_P + 4 * I_PW;
    for (int it = gw; it < NITEMS; it += NGW) {
        int r = it;
        if (r < I_IN) { transpose_item(a.in[1] + (size_t)l * D * DIN, D, DIN, (bf16*)(wsw + W_IN), scr, r, lane); continue; } r -= I_IN;
        if (r < I_UP) { transpose_item(a.in[16] + (size_t)l * D * DFF2, D, DFF2, (bf16*)(wsw + W_UP), scr, r, lane); continue; } r -= I_UP;
        if (r < I_DN) { transpose_item(a.in[19] + (size_t)l * DFF * D, DFF, D, (bf16*)(wsw + W_DOWN), scr, r, lane); continue; } r -= I_DN;
        if (r < I_OUT) { transpose_item(a.in[13] + (size_t)l * D * D, D, D, (bf16*)(wsw + W_OUT), scr, r, lane); continue; } r -= I_OUT;
        if (r < 3 * I_P) { const int br = r / I_P; transpose_item((br == 0 ? a.in[10] : (br == 1 ? a.in[11] : a.in[12])) + (size_t)l * WID * D, WID, D, (bf16*)(wsw + W_P) + (size_t)br * D * WID, scr, r % I_P, lane); continue; } r -= 3 * I_P;
        { const int g = r / I_PW; transpose_item(a.in[4] + ((size_t)l * 4 + g) * 65536, 256, 256, (bf16*)(wsw + W_PW) + (size_t)g * 65536, scr, r % I_PW, lane); }
    }
    const float* sw = a.in[8] + (size_t)l * 8 * 128 * 128; bf16* so = (bf16*)(wsw + W_SGW);
    for (int e = blockIdx.x * NT + tid; e < 8 * 128 * 128; e += gridDim.x * NT) { const int s = e & 127, t = (e >> 7) & 127; so[e] = (bf16)f2bf(s <= t ? sw[e] : 0.f); }
}

__device__ __forceinline__ void ln_rows(const float* T, const float* g, const float* b, float* outF, bf16* outB, int lane, int wave) {
    const int gw = blockIdx.x * NWAVES + wave, NGW = gridDim.x * NWAVES;
    for (int row = gw; row < M; row += NGW) {
        const f32x4* tr = (const f32x4*)(T + (size_t)row * D) + lane;
        f32x4 v[8]; float s = 0.f;
#pragma unroll
        for (int j = 0; j < 8; ++j) { v[j] = tr[64 * j]; s += (v[j][0] + v[j][1]) + (v[j][2] + v[j][3]); }
        const float mean = wave_sum(s) * (1.f / D); float s2 = 0.f;
#pragma unroll
        for (int j = 0; j < 8; ++j) { v[j] = v[j] - mean; s2 += (v[j][0] * v[j][0] + v[j][1] * v[j][1]) + (v[j][2] * v[j][2] + v[j][3] * v[j][3]); }
        const float rstd = 1.0f / sqrtf(wave_sum(s2) * (1.f / D) + LN_EPS);
#pragma unroll
        for (int j = 0; j < 8; ++j) {
            const f32x4 gg = ((const f32x4*)g)[64 * j + lane], bb = ((const f32x4*)b)[64 * j + lane];
            const f32x4 y = v[j] * rstd * gg + bb;
            if (outF) ((f32x4*)(outF + (size_t)row * D))[64 * j + lane] = y;
            if (outB) { u32x2 w; w.x = pk2(y[0], y[1]); w.y = pk2(y[2], y[3]); ((u32x2*)(outB + (size_t)row * D))[64 * j + lane] = w; }
        }
    }
}

__device__ __forceinline__ void sgu_stats(const bf16* Z, float* STAT, int lane, int wave) {
    const int gw = blockIdx.x * NWAVES + wave, NGW = gridDim.x * NWAVES;
    for (int row = gw; row < M; row += NGW) {
        const u32x4* p = (const u32x4*)(Z + (size_t)row * DIN + ZSV) + lane;
        const u32x4 a = p[0], c = p[64];
        float v[16] = {blo(a.x), bhi(a.x), blo(a.y), bhi(a.y), blo(a.z), bhi(a.z), blo(a.w), bhi(a.w), blo(c.x), bhi(c.x), blo(c.y), bhi(c.y), blo(c.z), bhi(c.z), blo(c.w), bhi(c.w)};
        float s = 0.f;
#pragma unroll
        for (int j = 0; j < 16; ++j) s += v[j];
        const float mean = wave_sum(s) * (1.f / 1024.f); float s2 = 0.f;
#pragma unroll
        for (int j = 0; j < 16; ++j) { const float d = v[j] - mean; s2 += d * d; }
        const float rstd = 1.0f / sqrtf(wave_sum(s2) * (1.f / 1024.f) + LN_EPS);
        if (lane == 0) { STAT[2 * row] = mean; STAT[2 * row + 1] = rstd; }
    }
}

__device__ __forceinline__ void hg_pass1(int item, LAS unsigned char* lds, const bf16* Z, const float* LF, float* UT, float* DEC, int tid, int lane, int wave) {
    const int bh = item >> 5, c = item & 31, b = bh >> 3, h = bh & 7, row0 = b * SEQ + c * 64;
    LAS bf16* KT = (LAS bf16*)lds;
    LAS bf16* VT = KT + 128 * 72;
    LAS float* tot = (LAS float*)(VT + 128 * 72);
    const int k = tid & 127, part = tid >> 7, s0 = part * 16;
    float lf[16]; unsigned kv[16], vv[16];
#pragma unroll
    for (int i = 0; i < 16; ++i) { const size_t row = (size_t)(row0 + s0 + i);
        lf[i] = LF[row * 1024 + h * 128 + k]; kv[i] = Z[row * DIN + ZK + h * 128 + k]; vv[i] = Z[row * DIN + ZV + h * 128 + k]; }
#pragma unroll
    for (int i = 1; i < 16; ++i) lf[i] += lf[i - 1];
    tot[part * 128 + k] = lf[15];
    __syncthreads();
    const float t0 = tot[k], t1 = tot[128 + k], t2 = tot[256 + k], t3 = tot[384 + k];
    const float prefix = (part > 0 ? t0 : 0.f) + (part > 1 ? t1 : 0.f) + (part > 2 ? t2 : 0.f);
    const float blast = ((t0 + t1) + t2) + t3;
    unsigned kw[8], vw[8];
#pragma unroll
    for (int i = 0; i < 8; ++i) {
        const float e0 = __expf(blast - (prefix + lf[2 * i])), e1 = __expf(blast - (prefix + lf[2 * i + 1]));
        kw[i] = pk2(bf2f((bf16)kv[2 * i]) * e0, bf2f((bf16)kv[2 * i + 1]) * e1);
        vw[i] = vv[2 * i] | (vv[2 * i + 1] << 16);
    }
    *(LAS u32x4*)(KT + k * 72 + s0) = (u32x4){kw[0], kw[1], kw[2], kw[3]}; *(LAS u32x4*)(KT + k * 72 + s0 + 8) = (u32x4){kw[4], kw[5], kw[6], kw[7]};
    *(LAS u32x4*)(VT + k * 72 + s0) = (u32x4){vw[0], vw[1], vw[2], vw[3]}; *(LAS u32x4*)(VT + k * 72 + s0 + 8) = (u32x4){vw[4], vw[5], vw[6], vw[7]};
    if (part == 0) DEC[(size_t)item * 128 + k] = __expf(blast);
    __syncthreads();
    f32x4 acc[8];
#pragma unroll
    for (int i = 0; i < 8; ++i) acc[i] = (f32x4){0.f, 0.f, 0.f, 0.f};
#pragma unroll
    for (int ks = 0; ks < 2; ++ks) {
        const bf16x8 bf = lfrag(VT, 72, 16 * wave, 32 * ks, lane);
#pragma unroll
        for (int kt = 0; kt < 8; ++kt) acc[kt] = MMA(lfrag(KT, 72, 16 * kt, 32 * ks, lane), bf, acc[kt]);
    }
    float* up = UT + (size_t)item * 16384 + (size_t)(16 * wave + (lane & 15)) * 128 + 4 * (lane >> 4);
#pragma unroll
    for (int kt = 0; kt < 8; ++kt) *(f32x4*)(up + 16 * kt) = acc[kt];
    __syncthreads();
}

__device__ __forceinline__ void hg_scan(const float* UT, const float* DEC, bf16* ST, int tid) {
    for (int e = blockIdx.x * NT + tid; e < 32 * 4096; e += gridDim.x * NT) {
        const int bh = e >> 12, r = e & 4095, v = r >> 5, k4 = (r & 31) * 4;
        f32x4 S = {0.f, 0.f, 0.f, 0.f};
#pragma unroll 4
        for (int c = 0; c < 32; ++c) {
            const size_t item = (size_t)bh * 32 + c;
            u32x2 w; w.x = pk2(S[0], S[1]); w.y = pk2(S[2], S[3]);
            *(u32x2*)(ST + item * 16384 + v * 128 + k4) = w;
            const f32x4 d = *(const f32x4*)(DEC + item * 128 + k4), u = *(const f32x4*)(UT + item * 16384 + v * 128 + k4);
            S = d * S + u;
        }
    }
}

__device__ __forceinline__ void hg_pass3(int item, LAS unsigned char* lds, const bf16* Z, const float* LF, const bf16* ST, const float* norm_g, bf16* Y, int tid, int lane, int wave) {
    const int bh = item >> 5, c = item & 31, b = bh >> 3, h = bh & 7, row0 = b * SEQ + c * 64;
    LAS bf16* Qpp = (LAS bf16*)lds;
    LAS bf16* Qp = Qpp + 64 * 136;
    LAS bf16* Kp = Qp + 64 * 136;
    LAS bf16* VT = Kp + 64 * 136;
    LAS bf16* P = VT + 128 * 72;
    LAS float* tot = (LAS float*)(P + 64 * 72);
    LAS float* ssq = tot + 512;
    const int k = tid & 127, part = tid >> 7, s0 = part * 16;
    {
        float lf[16]; unsigned qv[16], kv[16], vv[16];
#pragma unroll
        for (int i = 0; i < 16; ++i) { const size_t row = (size_t)(row0 + s0 + i);
            lf[i] = LF[row * 1024 + h * 128 + k]; qv[i] = Z[row * DIN + ZQ + h * 128 + k]; kv[i] = Z[row * DIN + ZK + h * 128 + k]; vv[i] = Z[row * DIN + ZV + h * 128 + k]; }
#pragma unroll
        for (int i = 1; i < 16; ++i) lf[i] += lf[i - 1];
        tot[part * 128 + k] = lf[15];
        __syncthreads();
        const float t0 = tot[k], t1 = tot[128 + k], t2 = tot[256 + k];
        const float prefix = (part > 0 ? t0 : 0.f) + (part > 1 ? t1 : 0.f) + (part > 2 ? t2 : 0.f);
        const float bmid = t0 + t1;
        unsigned vw[8];
#pragma unroll
        for (int i = 0; i < 16; ++i) {
            const float bb = prefix + lf[i], q = bf2f((bf16)qv[i]), kk = bf2f((bf16)kv[i]);
            const int s = s0 + i;
            Qpp[s * 136 + k] = (bf16)f2bf(q * __expf(bb));
            Qp[s * 136 + k] = (bf16)f2bf(q * __expf(bb - bmid));
            Kp[s * 136 + k] = (bf16)f2bf(kk * __expf(bmid - bb));
        }
#pragma unroll
        for (int i = 0; i < 8; ++i) vw[i] = vv[2 * i] | (vv[2 * i + 1] << 16);
        *(LAS u32x4*)(VT + k * 72 + s0) = (u32x4){vw[0], vw[1], vw[2], vw[3]}; *(LAS u32x4*)(VT + k * 72 + s0 + 8) = (u32x4){vw[4], vw[5], vw[6], vw[7]};
    }
    __syncthreads();
    const int fr = lane & 15, fq = lane >> 4;
    {
        const int ti = wave >> 1;
#pragma unroll
        for (int x = 0; x < 2; ++x) {
            const int si = 2 * (wave & 1) + x;
            f32x4 acc = {0.f, 0.f, 0.f, 0.f};
            if (si <= ti) {
#pragma unroll
                for (int ks = 0; ks < 4; ++ks) acc = MMA(lfrag(Kp, 136, 16 * si, 32 * ks, lane), lfrag(Qp, 136, 16 * ti, 32 * ks, lane), acc);
            }
            const int t = 16 * ti + fr, sb = 16 * si + 4 * fq;
            float p0 = (sb + 0 <= t) ? acc[0] : 0.f, p1 = (sb + 1 <= t) ? acc[1] : 0.f, p2 = (sb + 2 <= t) ? acc[2] : 0.f, p3 = (sb + 3 <= t) ? acc[3] : 0.f;
            u32x2 w; w.x = pk2(p0, p1); w.y = pk2(p2, p3);
            *(LAS u32x2*)(P + t * 72 + sb) = w;
        }
    }
    __syncthreads();
    const int ti = wave & 3, vt0 = 4 * (wave >> 2);
    f32x4 acc[4];
#pragma unroll
    for (int n = 0; n < 4; ++n) acc[n] = (f32x4){0.f, 0.f, 0.f, 0.f};
    const bf16* Sg = ST + (size_t)item * 16384;
#pragma unroll
    for (int ks = 0; ks < 4; ++ks) {
        const bf16x8 bf = lfrag(Qpp, 136, 16 * ti, 32 * ks, lane);
#pragma unroll
        for (int n = 0; n < 4; ++n) acc[n] = MMA(gfrag(Sg, 128, 16 * (vt0 + n), 32 * ks, lane), bf, acc[n]);
    }
#pragma unroll
    for (int ks = 0; ks < 2; ++ks) {
        const bf16x8 bf = lfrag(P, 72, 16 * ti, 32 * ks, lane);
#pragma unroll
        for (int n = 0; n < 4; ++n) acc[n] = MMA(lfrag(VT, 72, 16 * (vt0 + n), 32 * ks, lane), bf, acc[n]);
    }
    float ss = 0.f;
#pragma unroll
    for (int n = 0; n < 4; ++n) ss += (acc[n][0] * acc[n][0] + acc[n][1] * acc[n][1]) + (acc[n][2] * acc[n][2] + acc[n][3] * acc[n][3]);
    ss += __shfl_xor(ss, 16); ss += __shfl_xor(ss, 32);
    const int t = 16 * ti + fr;
    if (fq == 0) ssq[(wave >> 2) * 64 + t] = ss;
    __syncthreads();
    const float rinv = 1.0f / sqrtf((ssq[t] + ssq[64 + t]) * (1.f / 128.f) + RMS_EPS);
    const size_t row = (size_t)(row0 + t);
#pragma unroll
    for (int n = 0; n < 4; ++n) {
        const int col = h * 128 + 16 * (vt0 + n) + 4 * fq;
        const f32x4 g = *(const f32x4*)(norm_g + col);
        const u32x2 ow = *(const u32x2*)(Z + row * DIN + ZOG + col);
        const f32x4 y = {acc[n][0] * rinv * g[0] * blo(ow.x), acc[n][1] * rinv * g[1] * bhi(ow.x), acc[n][2] * rinv * g[2] * blo(ow.y), acc[n][3] * rinv * g[3] * bhi(ow.y)};
        u32x2 w; w.x = pk2(y[0], y[1]); w.y = pk2(y[2], y[3]);
        *(u32x2*)(Y + row * WID + col) = w;
    }
    __syncthreads();
}

__device__ __forceinline__ void pool_item(int item, LAS unsigned char* lds, const bf16* Z, const bf16* PWT, const float* scale, bf16* Y, int tid, int lane, int wave) {
    const int g = item & 3, tile = item >> 2, row0 = tile * 128, tseq0 = row0 & (SEQ - 1);
    const int w = 2 << g;
    LAS bf16* A = (LAS bf16*)lds;
    {
        const int cg8 = (tid & 31) * 8, run = tid >> 5;
        const bf16* zp = Z + ZP + g * 256 + cg8;
        float sum[8];
#pragma unroll
        for (int j = 0; j < 8; ++j) sum[j] = 0.f;
        const int ts0 = tseq0 + run * 8;
        for (int i = w - 1; i >= 1; --i) {
            if (ts0 - i >= 0) { const u32x4 p = *(const u32x4*)(zp + (size_t)(row0 + run * 8 - i) * DIN);
                sum[0] += blo(p.x); sum[1] += bhi(p.x); sum[2] += blo(p.y); sum[3] += bhi(p.y); sum[4] += blo(p.z); sum[5] += bhi(p.z); sum[6] += blo(p.w); sum[7] += bhi(p.w); }
        }
#pragma unroll
        for (int j = 0; j < 8; ++j) {
            const int tl = run * 8 + j, ts = tseq0 + tl;
            const u32x4 p = *(const u32x4*)(zp + (size_t)(row0 + tl) * DIN);
            const float cur[8] = {blo(p.x), bhi(p.x), blo(p.y), bhi(p.y), blo(p.z), bhi(p.z), blo(p.w), bhi(p.w)};
            const float inv = 1.0f / (float)((ts + 1) < w ? (ts + 1) : w);
            float o[8];
#pragma unroll
            for (int q = 0; q < 8; ++q) { sum[q] += cur[q]; o[q] = sum[q] * inv - cur[q]; }
            *(LAS u32x4*)(A + tl * 264 + cg8) = (u32x4){pk2(o[0], o[1]), pk2(o[2], o[3]), pk2(o[4], o[5]), pk2(o[6], o[7])};
            if (ts - w + 1 >= 0) { const u32x4 r = *(const u32x4*)(zp + (size_t)(row0 + tl - w + 1) * DIN);
                sum[0] -= blo(r.x); sum[1] -= bhi(r.x); sum[2] -= blo(r.y); sum[3] -= bhi(r.y); sum[4] -= blo(r.z); sum[5] -= bhi(r.z); sum[6] -= blo(r.w); sum[7] -= bhi(r.w); }
        }
    }
    __syncthreads();
    f32x4 acc[2][8];
#pragma unroll
    for (int n = 0; n < 2; ++n)
#pragma unroll
        for (int m = 0; m < 8; ++m) acc[n][m] = (f32x4){0.f, 0.f, 0.f, 0.f};
    const bf16* Wg = PWT + (size_t)g * 65536;
#pragma unroll 2
    for (int ks = 0; ks < 8; ++ks) {
        const bf16x8 a0 = gfrag(Wg, 256, 32 * wave, 32 * ks, lane), a1 = gfrag(Wg, 256, 32 * wave + 16, 32 * ks, lane);
#pragma unroll
        for (int m = 0; m < 8; ++m) { const bf16x8 bf = lfrag(A, 264, 16 * m, 32 * ks, lane); acc[0][m] = MMA(a0, bf, acc[0][m]); acc[1][m] = MMA(a1, bf, acc[1][m]); }
    }
    const int fr = lane & 15, fq = lane >> 4;
#pragma unroll
    for (int n = 0; n < 2; ++n) {
        const int col = g * 256 + 32 * wave + 16 * n + 4 * fq;
        const f32x4 sc = *(const f32x4*)(scale + col);
#pragma unroll
        for (int m = 0; m < 8; ++m) {
            const f32x4 y = acc[n][m] * sc;
            u32x2 wv; wv.x = pk2(y[0], y[1]); wv.y = pk2(y[2], y[3]);
            *(u32x2*)(Y + (size_t)(row0 + 16 * m + fr) * WID + col) = wv;
        }
    }
    __syncthreads();
}

__device__ __forceinline__ void sgu_item(int item, LAS unsigned char* lds, const bf16* Z, const float* STAT, const bf16* SGW, const float* ln_g, const float* ln_b, const float* sg_b, bf16* Y, int tid, int lane, int wave) {
    const int g = item & 7, chunk = item >> 3, row0 = chunk * 128;
    LAS bf16* VT = (LAS bf16*)lds;
    {
        const int d = tid & 127, part = tid >> 7;
        const float gg = ln_g[g * 128 + d], bb = ln_b[g * 128 + d];
        unsigned wv[16];
#pragma unroll
        for (int i = 0; i < 16; ++i) {
            const int s = part * 32 + 2 * i;
            const float v0 = bf2f(Z[(size_t)(row0 + s) * DIN + ZSV + g * 128 + d]), v1 = bf2f(Z[(size_t)(row0 + s + 1) * DIN + ZSV + g * 128 + d]);
            const float m0 = STAT[2 * (row0 + s)], r0 = STAT[2 * (row0 + s) + 1], m1 = STAT[2 * (row0 + s + 1)], r1 = STAT[2 * (row0 + s + 1) + 1];
            wv[i] = pk2((v0 - m0) * r0 * gg + bb, (v1 - m1) * r1 * gg + bb);
        }
#pragma unroll
        for (int i = 0; i < 4; ++i) *(LAS u32x4*)(VT + d * 136 + part * 32 + 8 * i) = (u32x4){wv[4 * i], wv[4 * i + 1], wv[4 * i + 2], wv[4 * i + 3]};
    }
    __syncthreads();
    f32x4 acc[8];
#pragma unroll
    for (int n = 0; n < 8; ++n) acc[n] = (f32x4){0.f, 0.f, 0.f, 0.f};
    const bf16* Wg = SGW + (size_t)g * 16384;
#pragma unroll
    for (int ks = 0; ks < 4; ++ks) {
        const bf16x8 bf = gfrag(Wg, 128, 16 * wave, 32 * ks, lane);
#pragma unroll
        for (int n = 0; n < 8; ++n) acc[n] = MMA(lfrag(VT, 136, 16 * n, 32 * ks, lane), bf, acc[n]);
    }
    const int fr = lane & 15, fq = lane >> 4, t = 16 * wave + fr;
    const float bs = sg_b[g * 128 + t];
    const size_t row = (size_t)(row0 + t);
#pragma unroll
    for (int n = 0; n < 8; ++n) {
        const int col = g * 128 + 16 * n + 4 * fq;
        const u32x2 uw = *(const u32x2*)(Z + row * DIN + ZU + col);
        const f32x4 y = {(acc[n][0] + bs) * blo(uw.x), (acc[n][1] + bs) * bhi(uw.x), (acc[n][2] + bs) * blo(uw.y), (acc[n][3] + bs) * bhi(uw.y)};
        u32x2 wv; wv.x = pk2(y[0], y[1]); wv.y = pk2(y[2], y[3]);
        *(u32x2*)(Y + row * WID + col) = wv;
    }
    __syncthreads();
}

__device__ __forceinline__ void conv_gate(const bf16* H, const float* cw, const float* cb, bf16* G, int tid) {
    constexpr int NCG = DFF / 8, RUN = 16, NRUN = M / RUN;
    for (int e = blockIdx.x * NT + tid; e < NCG * NRUN; e += gridDim.x * NT) {
        const int cgi = e % NCG, run = e / NCG, j0 = cgi * 8, r0 = run * RUN, ts0 = r0 & (SEQ - 1);
        float wa[3][8], wb[3][8], ba[8], bb[8];
#pragma unroll
        for (int q = 0; q < 8; ++q) {
#pragma unroll
            for (int i = 0; i < 3; ++i) { wa[i][q] = cw[i * DFF2 + j0 + q]; wb[i][q] = cw[i * DFF2 + DFF + j0 + q]; }
            ba[q] = cb[j0 + q]; bb[q] = cb[DFF + j0 + q];
        }
        float a2[8], a1[8], b2[8], b1[8];
#pragma unroll
        for (int q = 0; q < 8; ++q) { a2[q] = a1[q] = b2[q] = b1[q] = 0.f; }
        if (ts0 >= 2) {
            const u32x4 pa2 = *(const u32x4*)(H + (size_t)(r0 - 2) * DFF2 + j0), pa1 = *(const u32x4*)(H + (size_t)(r0 - 1) * DFF2 + j0);
            const u32x4 pb2 = *(const u32x4*)(H + (size_t)(r0 - 2) * DFF2 + DFF + j0), pb1 = *(const u32x4*)(H + (size_t)(r0 - 1) * DFF2 + DFF + j0);
            a2[0] = blo(pa2.x); a2[1] = bhi(pa2.x); a2[2] = blo(pa2.y); a2[3] = bhi(pa2.y); a2[4] = blo(pa2.z); a2[5] = bhi(pa2.z); a2[6] = blo(pa2.w); a2[7] = bhi(pa2.w);
            a1[0] = blo(pa1.x); a1[1] = bhi(pa1.x); a1[2] = blo(pa1.y); a1[3] = bhi(pa1.y); a1[4] = blo(pa1.z); a1[5] = bhi(pa1.z); a1[6] = blo(pa1.w); a1[7] = bhi(pa1.w);
            b2[0] = blo(pb2.x); b2[1] = bhi(pb2.x); b2[2] = blo(pb2.y); b2[3] = bhi(pb2.y); b2[4] = blo(pb2.z); b2[5] = bhi(pb2.z); b2[6] = blo(pb2.w); b2[7] = bhi(pb2.w);
            b1[0] = blo(pb1.x); b1[1] = bhi(pb1.x); b1[2] = blo(pb1.y); b1[3] = bhi(pb1.y); b1[4] = blo(pb1.z); b1[5] = bhi(pb1.z); b1[6] = blo(pb1.w); b1[7] = bhi(pb1.w);
        }
#pragma unroll 4
        for (int i = 0; i < RUN; ++i) {
            const size_t row = (size_t)(r0 + i);
            const u32x4 pa = *(const u32x4*)(H + row * DFF2 + j0), pb = *(const u32x4*)(H + row * DFF2 + DFF + j0);
            const float a0[8] = {blo(pa.x), bhi(pa.x), blo(pa.y), bhi(pa.y), blo(pa.z), bhi(pa.z), blo(pa.w), bhi(pa.w)};
            const float b0[8] = {blo(pb.x), bhi(pb.x), blo(pb.y), bhi(pb.y), blo(pb.z), bhi(pb.z), blo(pb.w), bhi(pb.w)};
            float o[8];
#pragma unroll
            for (int q = 0; q < 8; ++q) {
                const float ca = ba[q] + wa[0][q] * a2[q] + wa[1][q] * a1[q] + wa[2][q] * a0[q];
                const float cbv = bb[q] + wb[0][q] * b2[q] + wb[1][q] * b1[q] + wb[2][q] * b0[q];
                o[q] = ca * pg8::sigm(ca) * cbv;
                a2[q] = a1[q]; a1[q] = a0[q]; b2[q] = b1[q]; b1[q] = b0[q];
            }
            *(u32x4*)(G + row * DFF + j0) = (u32x4){pk2(o[0], o[1]), pk2(o[2], o[3]), pk2(o[4], o[5]), pk2(o[6], o[7])};
        }
    }
}

__global__ void __launch_bounds__(NT, 2) fwd_kernel(Args a) {
    extern __shared__ __attribute__((aligned(16))) unsigned char lds_raw[];
    LAS unsigned char* lds = (LAS unsigned char*)lds_raw;
    cg::grid_group grid = cg::this_grid();
    const int wave = __builtin_amdgcn_readfirstlane(threadIdx.x >> 6);
    const int lo = a.ph_lo, hi = a.ph_hi, G = gridDim.x, bx = blockIdx.x;
    unsigned char* ws = a.ws;
    float* LB = (float*)(ws + WS_LB); float* STAT = (float*)(ws + WS_STAT); float* DEC = (float*)(ws + WS_DEC);
    bf16* WinT = (bf16*)(ws + WS_W + W_IN); bf16* WupT = (bf16*)(ws + WS_W + W_UP); bf16* WdownT = (bf16*)(ws + WS_W + W_DOWN); bf16* WoutT = (bf16*)(ws + WS_W + W_OUT);
    bf16* PT = (bf16*)(ws + WS_W + W_P); bf16* PWT = (bf16*)(ws + WS_W + W_PW); bf16* SGW = (bf16*)(ws + WS_W + W_SGW);
    bf16* XB = (bf16*)(ws + WS_XB); bf16* Z = (bf16*)(ws + WS_Z); bf16* H = Z;
    float* LF = (float*)(ws + WS_MIX + MIX_LF); float* UT = (float*)(ws + WS_MIX + MIX_UT); bf16* ST = (bf16*)(ws + WS_MIX + MIX_ST);
    bf16* GB = (bf16*)(ws + WS_MIX + MIX_G); float* TMP = (float*)(ws + WS_MIX + MIX_TMP);
    bf16* Yhg = (bf16*)(ws + WS_Y); bf16* Ypool = Yhg + (size_t)M * WID; bf16* Ysg = Ypool + (size_t)M * WID;
    bf16* MG = (bf16*)(ws + WS_MG); float* T = (float*)(ws + WS_T); float* X1F = (float*)(ws + WS_X1F); bf16* X1B = (bf16*)(ws + WS_X1B);

    int ph = 0;
#define OPQ int tid_q = threadIdx.x; asm volatile("" : "+v"(tid_q)); const int tid = tid_q, lane = tid & 63; (void)lane;
#define PH_ON (ph >= lo && ph < hi)
#define PH_NEXT do { ++ph; if (ph > lo && ph < hi) grid.sync(); } while (0)

    for (int l = 0; l < DEPTH; ++l) {
        const float* XF = (l == 0) ? a.in[0] : a.out;
        if (PH_ON) { OPQ
            prep_weights(a, l, lds, tid, lane, wave);
            if (l == 0) {
                const f32x4* x4 = (const f32x4*)a.in[0]; u32x2* xb2 = (u32x2*)XB;
                for (int e = bx * NT + tid; e < M * D / 4; e += G * NT) { const f32x4 v = x4[e]; u32x2 w; w.x = pk2(v[0], v[1]); w.y = pk2(v[2], v[3]); xb2[e] = w; }
                for (int e = bx * NT + tid; e < 1024; e += G * NT) { const float a0 = a.in[2][e], a1 = a.in[2][1024 + e]; LB[e] = 0.f; LB[1024 + e] = 1.0f / (1.0f + expf(a0 - a1)); }
            }
        }
        PH_NEXT;
        if (PH_ON) { OPQ
            pg8::Gemm g{XB, WinT, M, DIN, D}; pg8::StaticOrder S; S.init(M, DIN, G, bx);
            pg8::EpiIn E{Z, LF, LB + l * 1024};
            pg8::gemm_phase<pg8::EpiIn, pg8::StaticOrder, true, true>(lds, g, S, E);
        }
        PH_NEXT;
        if (PH_ON) { OPQ
            for (int it = bx; it < 1024 + 256; it += G) {
                if (it < 1024) hg_pass1(it, lds, Z, LF, UT, DEC, tid, lane, wave);
                else pool_item(it - 1024, lds, Z, PWT, a.in[5] + l * WID, Ypool, tid, lane, wave);
            }
            sgu_stats(Z, STAT, lane, wave);
        }
        PH_NEXT;
        if (PH_ON) { OPQ
            hg_scan(UT, DEC, ST, tid);
            for (int it = bx; it < 512; it += G) sgu_item(it, lds, Z, STAT, SGW, a.in[6] + l * WID, a.in[7] + l * WID, a.in[9] + l * 1024, Ysg, tid, lane, wave);
        }
        PH_NEXT;
        if (PH_ON) { OPQ
            for (int it = bx; it < 1024; it += G) hg_pass3(it, lds, Z, LF, ST, a.in[3] + l * WID, Yhg, tid, lane, wave);
        }
        PH_NEXT;
        if (PH_ON) { OPQ
            pg8::StaticOrder S; S.init(M, D, G, bx);
            { pg8::Gemm g{Yhg, PT, M, D, WID}; pg8::EpiGate<0> E{Z + ZG, TMP, MG}; pg8::gemm_phase<pg8::EpiGate<0>, pg8::StaticOrder, false, true>(lds, g, S, E); }
            { pg8::Gemm g{Ypool, PT + (size_t)D * WID, M, D, WID}; pg8::EpiGate<1> E{Z + ZG + D, TMP, MG}; pg8::gemm_phase<pg8::EpiGate<1>, pg8::StaticOrder, false, true>(lds, g, S, E); }
            { pg8::Gemm g{Ysg, PT + (size_t)2 * D * WID, M, D, WID}; pg8::EpiGate<2> E{Z + ZG + 2 * D, TMP, MG}; pg8::gemm_phase<pg8::EpiGate<2>, pg8::StaticOrder, false, true>(lds, g, S, E); }
        }
        PH_NEXT;
        if (PH_ON) { OPQ
            pg8::Gemm g{MG, WoutT, M, D, D}; pg8::StaticOrder S; S.init(M, D, G, bx);
            pg8::EpiRes E{XF, T, DN_ALPHA};
            pg8::gemm_phase<pg8::EpiRes, pg8::StaticOrder, false, true>(lds, g, S, E);
        }
        PH_NEXT;
        if (PH_ON) { OPQ ln_rows(T, a.in[14] + l * D, a.in[15] + l * D, X1F, X1B, lane, wave); }
        PH_NEXT;
        if (PH_ON) { OPQ
            pg8::Gemm g{X1B, WupT, M, DFF2, D}; pg8::StaticOrder S; S.init(M, DFF2, G, bx);
            pg8::EpiStore E{H, DFF2};
            pg8::gemm_phase<pg8::EpiStore, pg8::StaticOrder, true, true>(lds, g, S, E);
        }
        PH_NEXT;
        if (PH_ON) { OPQ conv_gate(H, a.in[17] + (size_t)l * 3 * DFF2, a.in[18] + (size_t)l * DFF2, GB, tid); }
        PH_NEXT;
        if (PH_ON) { OPQ
            pg8::Gemm g{GB, WdownT, M, D, DFF}; pg8::StaticOrder S; S.init(M, D, G, bx);
            pg8::EpiRes E{X1F, T, DN_ALPHA};
            pg8::gemm_phase<pg8::EpiRes, pg8::StaticOrder, false, true>(lds, g, S, E);
        }
        PH_NEXT;
        if (PH_ON) { OPQ
            ln_rows(T, a.in[20] + l * D, a.in[21] + l * D, a.out, (l + 1 < DEPTH) ? XB : nullptr, lane, wave);
        }
        PH_NEXT;
    }
#undef PH_ON
#undef PH_NEXT
}
constexpr int N_PHASES = DEPTH * 12;

#ifndef MK_MULTI
#define MK_MULTI 0
#endif
extern "C" void kernel_launch(void* const* d_in, const int* in_sizes, int n_in, void* d_out, int out_size, void* d_ws, size_t ws_size, hipStream_t stream) {
    static int grid = 0;
    if (grid == 0) {
        if (n_in != 22 || out_size != M * D || ws_size < WS_END) { fprintf(stderr, "kernel_launch: unexpected shapes (n_in %d, out %d, ws %zu)\n", n_in, out_size, ws_size); grid = -1; return; }
        int dev = 0, cus = 0, per_cu = 0;
        hipGetDevice(&dev); hipDeviceGetAttribute(&cus, hipDeviceAttributeMultiprocessorCount, dev);
        if (hipFuncSetAttribute((const void*)fwd_kernel, hipFuncAttributeMaxDynamicSharedMemorySize, LDS_BYTES) != hipSuccess) { fprintf(stderr, "kernel_launch: hipFuncSetAttribute failed\n"); grid = -1; return; }
        hipOccupancyMaxActiveBlocksPerMultiprocessor(&per_cu, (const void*)fwd_kernel, NT, LDS_BYTES);
        (void)hipGetLastError();
        if (per_cu < 1) per_cu = 1;
        grid = cus * 1;
        fprintf(stderr, "kernel_launch: cus %d per_cu %d grid %d\n", cus, per_cu, grid);
    }
    if (grid < 0) return;
    Args a{};
    for (int i = 0; i < 22; ++i) a.in[i] = (const float*)d_in[i];
    a.out = (float*)d_out; a.ws = (unsigned char*)d_ws;
#if MK_MULTI
    for (int p = 0; p < N_PHASES; ++p) { a.ph_lo = p; a.ph_hi = p + 1; hipLaunchKernelGGL(fwd_kernel, dim3(grid), dim3(NT), LDS_BYTES, stream, a); }
#else
    a.ph_lo = 0; a.ph_hi = N_PHASES;
    void* args[] = {&a};
    hipError_t e = hipLaunchCooperativeKernel((const void*)fwd_kernel, dim3(grid), dim3(NT), args, LDS_BYTES, stream);
    if (e != hipSuccess) fprintf(stderr, "cooperative launch failed: %s (grid %d)\n", hipGetErrorString(e), grid);
#endif
}
```

```cpp
#include <hip/hip_runtime.h>
#include <hip/hip_cooperative_groups.h>
#include <cstdio>
#include <cstdint>
namespace cg = cooperative_groups;
namespace pg8 {
#define PG8_LAS __attribute__((address_space(3)))
typedef unsigned short bf16_t;
typedef short bf16x8 __attribute__((ext_vector_type(8)));
typedef float f32x4 __attribute__((ext_vector_type(4)));
typedef unsigned u32x4 __attribute__((ext_vector_type(4)));
constexpr int BM = 256, BK = 64, HALF = 128, HTB = HALF * BK * 2  , STAGE_BYTES = 8 * HTB, NXCD = 8, WGM = 8;

__host__ __device__ __forceinline__ int lds_byte(int r, int c) { const int st = (r >> 4) * 2 + (c >> 5), rr = r & 15, cc = c & 31, ob = rr * 64 + cc * 2; return st * 1024 + (ob ^ (((ob >> 9) & 1) << 5)); }
__host__ __device__ __forceinline__ void stage_rc(int b, int& R, int& C) { const int st = b / 1024, sb = b % 1024, swz = sb ^ (((sb >> 9) & 1) << 5); R = (st >> 1) * 16 + swz / 64; C = (st & 1) * 32 + (swz % 64) / 2; }
__host__ __device__ __forceinline__ int perm32(int rho) { const int n = rho >> 4, i = rho & 15; return 8 * (i >> 2) + 4 * n + (i & 3); }

struct Unit { int pm, pn; };
struct Gemm { const bf16_t* A; const bf16_t* Bt; int M, N, K; };

struct StaticOrder {
    int nM, nN, nwg, G, c;
    __host__ __device__ void init(int M, int N, int G_, int c_) { nM = M / BM; nN = N / BM; nwg = nM * nN; G = G_; c = c_; }
    __host__ __device__ bool next(int i, Unit& u) const {
        const long L = (long)i * G + c; if (L >= nwg) return false;
        int wgid = (int)L; { const int q = nwg / NXCD, r = nwg % NXCD, xcd = wgid % NXCD, off = wgid / NXCD; wgid = (xcd < r ? xcd * (q + 1) : r * (q + 1) + (xcd - r) * q) + off; }
        const int nig = WGM * nN, gid = wgid / nig, fm = gid * WGM, gsz = (nM - fm) < WGM ? (nM - fm) : WGM;
        u.pm = fm + ((wgid % nig) % gsz); u.pn = (wgid % nig) / gsz; return true;
    }
    __device__ __forceinline__ void a_ready(const Unit&) const {}
    __device__ __forceinline__ void done(const Unit&) const {}
};
__device__ __forceinline__ unsigned cvt_pk_bf16(float lo, float hi) { unsigned r; asm volatile("v_cvt_pk_bf16_f32 %0, %1, %2" : "=v"(r) : "v"(lo), "v"(hi)); return r; }
typedef float f32x2 __attribute__((ext_vector_type(2)));
__device__ __forceinline__ float bf_lo(unsigned w) { return __uint_as_float(w << 16); }
__device__ __forceinline__ float bf_hi(unsigned w) { return __uint_as_float(w & 0xffff0000u); }
__device__ __forceinline__ float sigm(float t) { return __builtin_amdgcn_rcpf(1.0f + __expf(-t)); }

struct EpiIn {
    static constexpr bool PERM = true, AFTER_DRAIN = false;
    bf16_t* Z; float* LF; const float* lb;
    __device__ __forceinline__ void operator()(const f32x4 (&acc)[2][2][4][2], const Unit& u, int wr, int wc, int fr, int fq) const {
        const int sec = u.pn >> 2;
        const int row0 = u.pm * BM + wr * 64 + fr, col0 = u.pn * BM + wc * 32 + 8 * fq;
        if (sec == 1) {
#pragma unroll
            for (int bj = 0; bj < 2; ++bj) {
                const int kc = col0 + bj * HALF - 1024;
                const f32x4 l0 = *(const f32x4*)(lb + kc), l1 = *(const f32x4*)(lb + kc + 4);
#pragma unroll
                for (int ai = 0; ai < 2; ++ai)
#pragma unroll
                    for (int m = 0; m < 4; ++m) {
                        const size_t row = (size_t)(row0 + ai * HALF + m * 16);
                        f32x4 lf0, lf1, k0, k1;
#pragma unroll
                        for (int j = 0; j < 4; ++j) {
                            { float x = fminf(fmaxf(acc[ai][bj][m][0][j], -80.f), 80.f); const float e = __expf(-x), s = __builtin_amdgcn_rcpf(1.0f + e), sm = e * s, l = l0[j];
                              lf0[j] = __logf(l + (1.0f - l) * s); k0[j] = (1.0f - l) * sm; }
                            { float x = fminf(fmaxf(acc[ai][bj][m][1][j], -80.f), 80.f); const float e = __expf(-x), s = __builtin_amdgcn_rcpf(1.0f + e), sm = e * s, l = l1[j];
                              lf1[j] = __logf(l + (1.0f - l) * s); k1[j] = (1.0f - l) * sm; }
                        }
                        *(f32x4*)(LF + row * 1024 + kc) = lf0; *(f32x4*)(LF + row * 1024 + kc + 4) = lf1;
                        u32x4 w; w.x = cvt_pk_bf16(k0[0], k0[1]); w.y = cvt_pk_bf16(k0[2], k0[3]); w.z = cvt_pk_bf16(k1[0], k1[1]); w.w = cvt_pk_bf16(k1[2], k1[3]);
                        *(u32x4*)(Z + row * 13312 + col0 + bj * HALF) = w;
                    }
            }
        } else {
            float c1 = 1.0f, c3 = 0.0f; bool fx = true, fs = true;
            if (sec == 2 || sec == 4) fs = false;
            else if (sec == 5 || sec == 6) { c1 = 1.5957691216057308f; c3 = 0.044715f; }
            else if (sec >= 7) fx = false;
#pragma unroll
            for (int ai = 0; ai < 2; ++ai)
#pragma unroll
                for (int m = 0; m < 4; ++m) {
                    const size_t row = (size_t)(row0 + ai * HALF + m * 16);
#pragma unroll
                    for (int bj = 0; bj < 2; ++bj) {
                        f32x4 v0 = acc[ai][bj][m][0], v1 = acc[ai][bj][m][1];
                        if (fs) {
#pragma unroll
                            for (int j = 0; j < 4; ++j) {
                                { const float x = v0[j], s = sigm(c1 * x * (1.0f + c3 * x * x)); v0[j] = fx ? x * s : s; }
                                { const float x = v1[j], s = sigm(c1 * x * (1.0f + c3 * x * x)); v1[j] = fx ? x * s : s; }
                            }
                        }
                        u32x4 w; w.x = cvt_pk_bf16(v0[0], v0[1]); w.y = cvt_pk_bf16(v0[2], v0[3]); w.z = cvt_pk_bf16(v1[0], v1[1]); w.w = cvt_pk_bf16(v1[2], v1[3]);
                        *(u32x4*)(Z + row * 13312 + col0 + bj * HALF) = w;
                    }
                }
        }
    }
};

struct EpiStore {
    static constexpr bool PERM = true, AFTER_DRAIN = false;
    bf16_t* O; int ldc;
    __device__ __forceinline__ void operator()(const f32x4 (&acc)[2][2][4][2], const Unit& u, int wr, int wc, int fr, int fq) const {
        const int row0 = u.pm * BM + wr * 64 + fr, col0 = u.pn * BM + wc * 32 + 8 * fq;
#pragma unroll
        for (int ai = 0; ai < 2; ++ai)
#pragma unroll
            for (int m = 0; m < 4; ++m) {
                bf16_t* rowp = O + (size_t)(row0 + ai * HALF + m * 16) * ldc + col0;
#pragma unroll
                for (int bj = 0; bj < 2; ++bj) {
                    const f32x4 v0 = acc[ai][bj][m][0], v1 = acc[ai][bj][m][1];
                    u32x4 w; w.x = cvt_pk_bf16(v0[0], v0[1]); w.y = cvt_pk_bf16(v0[2], v0[3]); w.z = cvt_pk_bf16(v1[0], v1[1]); w.w = cvt_pk_bf16(v1[2], v1[3]);
                    *(u32x4*)(rowp + bj * HALF) = w;
                }
            }
    }
};

template <int MODE> struct EpiGate {
    static constexpr bool PERM = true, AFTER_DRAIN = false;
    const bf16_t* G; float* TMP; bf16_t* MG;
    __device__ __forceinline__ void operator()(const f32x4 (&acc)[2][2][4][2], const Unit& u, int wr, int wc, int fr, int fq) const {
        const int row0 = u.pm * BM + wr * 64 + fr, col0 = u.pn * BM + wc * 32 + 8 * fq;
#pragma unroll
        for (int ai = 0; ai < 2; ++ai)
#pragma unroll
            for (int m = 0; m < 4; ++m) {
                const size_t row = (size_t)(row0 + ai * HALF + m * 16);
#pragma unroll
                for (int bj = 0; bj < 2; ++bj) {
                    const int col = col0 + bj * HALF;
                    const u32x4 gw = *(const u32x4*)(G + row * 13312 + col);
                    f32x4 g0 = {bf_lo(gw.x), bf_hi(gw.x), bf_lo(gw.y), bf_hi(gw.y)}, g1 = {bf_lo(gw.z), bf_hi(gw.z), bf_lo(gw.w), bf_hi(gw.w)};
                    f32x4 v0 = acc[ai][bj][m][0] * g0, v1 = acc[ai][bj][m][1] * g1;
                    float* tp = TMP + row * 2048 + col;
                    if (MODE >= 1) { v0 += *(const f32x4*)tp; v1 += *(const f32x4*)(tp + 4); }
                    if (MODE <= 1) { *(f32x4*)tp = v0; *(f32x4*)(tp + 4) = v1; }
                    else { u32x4 w; w.x = cvt_pk_bf16(v0[0], v0[1]); w.y = cvt_pk_bf16(v0[2], v0[3]); w.z = cvt_pk_bf16(v1[0], v1[1]); w.w = cvt_pk_bf16(v1[2], v1[3]);
                        *(u32x4*)(MG + row * 2048 + col) = w; }
                }
            }
    }
};

struct EpiRes {
    static constexpr bool PERM = true, AFTER_DRAIN = false;
    const float* R; float* T; float alpha;
    __device__ __forceinline__ void operator()(const f32x4 (&acc)[2][2][4][2], const Unit& u, int wr, int wc, int fr, int fq) const {
        const int row0 = u.pm * BM + wr * 64 + fr, col0 = u.pn * BM + wc * 32 + 8 * fq;
#pragma unroll
        for (int ai = 0; ai < 2; ++ai)
#pragma unroll
            for (int m = 0; m < 4; ++m) {
                const size_t row = (size_t)(row0 + ai * HALF + m * 16);
#pragma unroll
                for (int bj = 0; bj < 2; ++bj) {
                    const size_t o = row * 2048 + col0 + bj * HALF;
                    const f32x4 r0 = *(const f32x4*)(R + o), r1 = *(const f32x4*)(R + o + 4);
                    *(f32x4*)(T + o) = r0 * alpha + acc[ai][bj][m][0]; *(f32x4*)(T + o + 4) = r1 * alpha + acc[ai][bj][m][1];
                }
            }
    }
};
template <class Epi, class Sched, bool ALIGN_EPI = false, bool SP2 = false>
__device__ __forceinline__ void gemm_phase(PG8_LAS unsigned char* lds, const Gemm g, const Sched& S, const Epi& E) {
    int tid_o = threadIdx.x; asm volatile("" : "+v"(tid_o));
    const int tid = tid_o, wid = __builtin_amdgcn_readfirstlane(tid >> 6), lane = tid & 63, wr = wid >> 2, wc = wid & 3, fr = lane & 15, fq = lane >> 4;
    const int K = g.K, nt = K / BK;
    unsigned voffA[2], voffB[2];
#pragma unroll
    for (int i = 0; i < 2; ++i) { int R, C; stage_rc(tid * 16 + i * 8192, R, C); const int Rb = Epi::PERM ? ((R & ~31) + perm32(R & 31)) : R;
        voffA[i] = (unsigned)(R * K + C) * 2u; voffB[i] = (unsigned)(Rb * K + C) * 2u; }
    const size_t kstep = (size_t)(BK * 2);
    const size_t hstep = (size_t)HALF * K * 2;
    const size_t tstep = 2 * hstep;
    const unsigned ldsw = (unsigned)wid * 1024u;
    const int aoff = lds_byte(wr * 64 + fr, fq * 8), boff = lds_byte(wc * 32 + fr, fq * 8);
#define PG8_SA(b, h) (((b) * 2 + (h)) * HTB)
#define PG8_SB(b, h) ((4 + (b) * 2 + (h)) * HTB)
#define PG8_STAGE(bufoff, gbase, voff) do { _Pragma("unroll") for (int _i = 0; _i < 2; ++_i) \
        __builtin_amdgcn_global_load_lds((const unsigned*)((const char*)(gbase) + (voff)[_i]), (PG8_LAS unsigned*)(lds + (bufoff) + ldsw + _i * 8192), 16, 0, 0); } while (0)
#define PG8_LDA(dst, b, h) do { _Pragma("unroll") for (int m = 0; m < 4; ++m) _Pragma("unroll") for (int k = 0; k < 2; ++k) dst[m][k] = *(const PG8_LAS bf16x8*)(lds + PG8_SA(b, h) + aoff + m * 2048 + k * 1024); } while (0)
#define PG8_LDB(dst, b, h) do { _Pragma("unroll") for (int n = 0; n < 2; ++n) _Pragma("unroll") for (int k = 0; k < 2; ++k) dst[n][k] = *(const PG8_LAS bf16x8*)(lds + PG8_SB(b, h) + boff + n * 2048 + k * 1024); } while (0)
#define PG8_MMA(ai, bj, At, Bt) do { __builtin_amdgcn_s_setprio(1); _Pragma("unroll") for (int m = 0; m < 4; ++m) _Pragma("unroll") for (int n = 0; n < 2; ++n) _Pragma("unroll") for (int k = 0; k < 2; ++k) \
        acc[ai][bj][m][n] = __builtin_amdgcn_mfma_f32_16x16x32_bf16(Bt[n][k], At[m][k], acc[ai][bj][m][n], 0, 0, 0); __builtin_amdgcn_s_setprio(0); } while (0)
#define PG8_WAIT_V(n) asm volatile("s_waitcnt vmcnt(" #n ")" ::: "memory")
#define PG8_WAIT_L(n) asm volatile("s_waitcnt lgkmcnt(" #n ")" ::: "memory")
#define PG8_BAR __builtin_amdgcn_s_barrier()
#define PG8_SCHED __builtin_amdgcn_sched_barrier(0)
    Unit cur, nxt; int ui = 0;
    if (!S.next(0, cur)) return;
    f32x4 acc[2][2][4][2];
#pragma unroll
    for (int a = 0; a < 2; ++a)
#pragma unroll
        for (int b = 0; b < 2; ++b)
#pragma unroll
            for (int m = 0; m < 4; ++m)
#pragma unroll
                for (int n = 0; n < 2; ++n) acc[a][b][m][n] = (f32x4){0.f, 0.f, 0.f, 0.f};
    bf16x8 At[4][2], B0[2][2], B1[2][2];
    const char* cA = (const char*)g.A + (size_t)cur.pm * tstep; const char* cB = (const char*)g.Bt + (size_t)cur.pn * tstep;
    S.a_ready(cur);
    if constexpr (SP2) {
        PG8_STAGE(PG8_SB(0, 0), cB, voffB); PG8_STAGE(PG8_SB(0, 1), cB + hstep, voffB); PG8_STAGE(PG8_SA(0, 0), cA, voffA); PG8_STAGE(PG8_SA(0, 1), cA + hstep, voffA);
        if (wr == 1) PG8_BAR;
        PG8_WAIT_V(2); PG8_BAR;
        PG8_STAGE(PG8_SB(1, 0), cB + kstep, voffB); PG8_STAGE(PG8_SA(1, 0), cA + kstep, voffA); PG8_STAGE(PG8_SB(1, 1), cB + hstep + kstep, voffB);
        PG8_WAIT_V(6); PG8_BAR;
    } else {
        PG8_STAGE(PG8_SB(0, 0), cB, voffB); PG8_STAGE(PG8_SA(0, 0), cA, voffA); PG8_STAGE(PG8_SB(0, 1), cB + hstep, voffB); PG8_STAGE(PG8_SA(0, 1), cA + hstep, voffA);
        if (wr == 1) PG8_BAR;
        PG8_WAIT_V(4); PG8_BAR;
        PG8_STAGE(PG8_SB(1, 0), cB + kstep, voffB); PG8_STAGE(PG8_SA(1, 0), cA + kstep, voffA); PG8_STAGE(PG8_SB(1, 1), cB + hstep + kstep, voffB);
        PG8_WAIT_V(6); PG8_BAR;
    }
    for (;;) {
        const bool has_next = S.next(ui + 1, nxt);
        const char* nA = has_next ? (const char*)g.A + (size_t)nxt.pm * tstep : cA; const char* nB = has_next ? (const char*)g.Bt + (size_t)nxt.pn * tstep : cB;
        for (int t = 0; t < nt; t += 2) {
            const bool last = (t == nt - 2);
            const char* a1 = cA + (size_t)(t + 1) * kstep;
            const char* a2 = last ? nA : cA + (size_t)(t + 2) * kstep; const char* b2 = last ? nB : cB + (size_t)(t + 2) * kstep;
            const char* a3 = a2 + kstep; const char* b3 = b2 + kstep;
            if (last && has_next) S.a_ready(nxt);
            if constexpr (SP2) {
            PG8_LDB(B0, 0, 0); PG8_LDB(B1, 0, 1); PG8_SCHED; PG8_LDA(At, 0, 0); PG8_STAGE(PG8_SA(1, 1), a1 + hstep, voffA);
            PG8_WAIT_V(8); PG8_WAIT_L(0); PG8_BAR; PG8_MMA(0, 0, At, B0); PG8_MMA(0, 1, At, B1); PG8_BAR; PG8_SCHED;
            PG8_LDA(At, 0, 1); PG8_STAGE(PG8_SB(0, 0), b2, voffB); PG8_STAGE(PG8_SB(0, 1), b2 + hstep, voffB); PG8_STAGE(PG8_SA(0, 0), a2, voffA);
            PG8_WAIT_V(8); PG8_WAIT_L(0); PG8_BAR; PG8_MMA(1, 0, At, B0); PG8_MMA(1, 1, At, B1); PG8_BAR; PG8_SCHED;
            PG8_LDB(B0, 1, 0); PG8_LDB(B1, 1, 1); PG8_SCHED; PG8_LDA(At, 1, 0); PG8_STAGE(PG8_SA(0, 1), a2 + hstep, voffA);
            PG8_WAIT_V(8); PG8_WAIT_L(0); PG8_BAR; PG8_MMA(0, 0, At, B0); PG8_MMA(0, 1, At, B1); PG8_BAR; PG8_SCHED;
            PG8_LDA(At, 1, 1); PG8_STAGE(PG8_SB(1, 0), b3, voffB); PG8_STAGE(PG8_SB(1, 1), b3 + hstep, voffB); PG8_STAGE(PG8_SA(1, 0), a3, voffA);
            PG8_WAIT_V(8); PG8_WAIT_L(0); PG8_BAR; PG8_MMA(1, 0, At, B0); PG8_MMA(1, 1, At, B1); PG8_BAR; PG8_SCHED;
            } else {
            PG8_LDB(B0, 0, 0); PG8_SCHED; PG8_LDA(At, 0, 0); PG8_STAGE(PG8_SA(1, 1), a1 + hstep, voffA);
            PG8_WAIT_L(8); PG8_BAR; PG8_WAIT_L(0); PG8_MMA(0, 0, At, B0); PG8_BAR; PG8_SCHED;
            PG8_LDB(B1, 0, 1); PG8_STAGE(PG8_SB(0, 0), b2, voffB);
            PG8_BAR; PG8_WAIT_L(0); PG8_MMA(0, 1, At, B1); PG8_BAR;
            PG8_LDA(At, 0, 1); PG8_STAGE(PG8_SA(0, 0), a2, voffA);
            PG8_BAR; PG8_WAIT_L(0); PG8_MMA(1, 0, At, B0); PG8_BAR; PG8_SCHED;
            PG8_STAGE(PG8_SB(0, 1), b2 + hstep, voffB);
            PG8_WAIT_V(6); PG8_BAR; PG8_MMA(1, 1, At, B1); PG8_BAR;
            PG8_LDB(B0, 1, 0); PG8_SCHED; PG8_LDA(At, 1, 0); PG8_STAGE(PG8_SA(0, 1), a2 + hstep, voffA);
            PG8_WAIT_L(8); PG8_BAR; PG8_WAIT_L(0); PG8_MMA(0, 0, At, B0); PG8_BAR; PG8_SCHED;
            PG8_LDB(B1, 1, 1); PG8_STAGE(PG8_SB(1, 0), b3, voffB);
            PG8_BAR; PG8_WAIT_L(0); PG8_MMA(0, 1, At, B1); PG8_BAR;
            PG8_LDA(At, 1, 1); PG8_STAGE(PG8_SA(1, 0), a3, voffA);
            PG8_BAR; PG8_WAIT_L(0); PG8_MMA(1, 0, At, B0); PG8_BAR; PG8_SCHED;
            PG8_STAGE(PG8_SB(1, 1), b3 + hstep, voffB);
            PG8_WAIT_V(6); PG8_BAR; PG8_MMA(1, 1, At, B1); PG8_BAR;
            }
        }
        if constexpr (ALIGN_EPI) { if (wr == 0) PG8_BAR; }
        if constexpr (!Epi::AFTER_DRAIN) { E(acc, cur, wr, wc, fr, fq); S.done(cur); }
        if (!has_next) break;
#pragma unroll
        for (int a = 0; a < 2; ++a)
#pragma unroll
            for (int b = 0; b < 2; ++b)
#pragma unroll
                for (int m = 0; m < 4; ++m)
#pragma unroll
                    for (int n = 0; n < 2; ++n) acc[a][b][m][n] = (f32x4){0.f, 0.f, 0.f, 0.f};
        cur = nxt; cA = nA; cB = nB; ++ui;
        if constexpr (ALIGN_EPI) { if (wr == 1) PG8_BAR; }
    }
    PG8_WAIT_V(0);
    if constexpr (!ALIGN_EPI) { if (wr == 0) PG8_BAR; }
    PG8_BAR;
    if constexpr (Epi::AFTER_DRAIN) { E.fused(acc, cur, wr, wc, fr, fq, lds, wid, lane); S.done(cur); }
#undef PG8_SA
#undef PG8_SB
#undef PG8_STAGE
#undef PG8_LDA
#undef PG8_LDB
#undef PG8_MMA
#undef PG8_WAIT_V
#undef PG8_WAIT_L
#undef PG8_BAR
#undef PG8_SCHED
}
}

constexpr int BATCH = 4, SEQ = 2048, D = 2048, M = BATCH * SEQ, DIN = 13312, WID = 1024, DFF = 5632, DFF2 = 11264, DEPTH = 2;
constexpr int ZQ = 0, ZK = 1024, ZV = 2048, ZOG = 3072, ZP = 4096, ZU = 5120, ZSV = 6144, ZG = 7168;
constexpr float LN_EPS = 1e-5f, RMS_EPS = 1e-6f, DN_ALPHA = 1.4142135623730951f;
constexpr int NWAVES = 8, NT = 512;
constexpr size_t MiB = 1u << 20;
constexpr size_t WS_LB = 0, WS_BAR = 16 * 1024, WS_STAT = 64 * 1024, WS_DEC = 1 * MiB;
constexpr size_t WS_W = 2 * MiB, W_IN = 0, W_UP = 52 * MiB, W_DOWN = 96 * MiB, W_OUT = 118 * MiB, W_P = 126 * MiB, W_PW = 138 * MiB, W_SGW = 138 * MiB + 512 * 1024;
constexpr size_t WS_XB = 142 * MiB, WS_Z = 174 * MiB, WS_MIX = 382 * MiB, WS_Y = 510 * MiB, WS_MG = 558 * MiB, WS_T = 590 * MiB, WS_X1F = 654 * MiB, WS_X1B = 718 * MiB, WS_END = 750 * MiB;
constexpr size_t MIX_LF = 0, MIX_UT = 32 * MiB, MIX_ST = 96 * MiB, MIX_G = 0, MIX_TMP = 32 * MiB;
constexpr int LDS_BYTES = 147456;

#define LAS __attribute__((address_space(3)))
typedef unsigned short bf16;
typedef short bf16x8 __attribute__((ext_vector_type(8)));
typedef float f32x4 __attribute__((ext_vector_type(4)));
typedef unsigned u32x4 __attribute__((ext_vector_type(4)));
typedef unsigned u32x2 __attribute__((ext_vector_type(2)));

__device__ __forceinline__ float bf2f(bf16 b) { return __uint_as_float(((unsigned)b) << 16); }
__device__ __forceinline__ unsigned f2bf(float f) { unsigned u = __float_as_uint(f); return (u + 0x7fffu + ((u >> 16) & 1u)) >> 16; }
__device__ __forceinline__ unsigned pk2(float lo, float hi) { return pg8::cvt_pk_bf16(lo, hi); }
__device__ __forceinline__ float blo(unsigned w) { return __uint_as_float(w << 16); }
__device__ __forceinline__ float bhi(unsigned w) { return __uint_as_float(w & 0xffff0000u); }
__device__ __forceinline__ float wave_sum(float v) {
#pragma unroll
    for (int o = 1; o < 64; o <<= 1) v += __shfl_xor(v, o);
    return v;
}
__device__ __forceinline__ bf16x8 lfrag(const LAS bf16* base, int pitch, int row0, int k0, int lane) {
    return *(const LAS bf16x8*)(base + (row0 + (lane & 15)) * pitch + k0 + 8 * (lane >> 4));
}
__device__ __forceinline__ bf16x8 gfrag(const bf16* base, int pitch, int row0, int k0, int lane) {
    return *(const bf16x8*)(base + (size_t)(row0 + (lane & 15)) * pitch + k0 + 8 * (lane >> 4));
}
#define MMA(a, b, c) __builtin_amdgcn_mfma_f32_16x16x32_bf16((a), (b), (c), 0, 0, 0)

__device__ __forceinline__ void transpose_item(const float* W, int K, int N, bf16* WT, LAS float* scr, int item, int lane) {
    const int nblk = N / 32, kb = item / nblk, nb = item % nblk, k0 = 64 * kb, n0 = 32 * nb;
#pragma unroll 8
    for (int i = 0; i < 32; ++i) { const int kk = 2 * i + (lane >> 5); scr[kk * 33 + (lane & 31)] = W[(size_t)(k0 + kk) * N + n0 + (lane & 31)]; }
    asm volatile("s_waitcnt lgkmcnt(0)" ::: "memory");
    const int c = lane & 7;
#pragma unroll
    for (int j = 0; j < 4; ++j) { const int n = (lane >> 3) + 8 * j; const LAS float* s = scr + (8 * c) * 33 + n;
        u32x4 o; o.x = pk2(s[0 * 33], s[1 * 33]); o.y = pk2(s[2 * 33], s[3 * 33]); o.z = pk2(s[4 * 33], s[5 * 33]); o.w = pk2(s[6 * 33], s[7 * 33]);
        *(u32x4*)(WT + (size_t)(n0 + n) * K + k0 + 8 * c) = o; }
    asm volatile("s_waitcnt lgkmcnt(0)" ::: "memory");
}

#define XB_TMO      128
#define XB_XCNT(j)  (256  + 64 * (j))
#define XB_XSUB(j)  (1280 + 64 * (j))
#define XB_XGEN(j)  (2304 + 64 * (j))
#define XB_TOP      3328
#define XB_TOPGEN   3392
#define XCD_BAR_WORDS 3456
#define XB_SPIN_CAP (1u << 18)

__device__ __forceinline__ unsigned xb_ld(unsigned* p)              { return __hip_atomic_load(p, __ATOMIC_RELAXED, __HIP_MEMORY_SCOPE_AGENT); }
__device__ __forceinline__ unsigned xb_add(unsigned* p, unsigned v) { return __hip_atomic_fetch_add(p, v, __ATOMIC_RELAXED, __HIP_MEMORY_SCOPE_AGENT); }
__device__ __forceinline__ unsigned xb_xcc_id() { return (unsigned)__builtin_amdgcn_s_getreg((3 << 11) | 20) & 0xFu; }
#define XB_SPIN(cond, bar) do { unsigned _sp = 0; while (cond) { __builtin_amdgcn_s_sleep(1); \
    if ((++_sp & 255u) == 0u) { if (xb_ld(&(bar)[XB_TMO])) break; if (_sp > XB_SPIN_CAP) { atomicAdd(&(bar)[XB_TMO], 1u); break; } } } } while (0)

struct XcdBarrier {
    unsigned* bar; unsigned x;
    volatile LAS unsigned* st;
};

__device__ __forceinline__ XcdBarrier xcd_barrier_post(unsigned* bar, volatile LAS unsigned* st) {
    XcdBarrier b; b.bar = bar; b.x = xb_xcc_id(); b.st = st;
    if (threadIdx.x == 0) (void)xb_add(&bar[XB_XCNT(b.x)], 1u);
    return b;
}
__device__ __forceinline__ void xcd_barrier_complete(unsigned* bar, unsigned x, unsigned& nloc, unsigned& nx) {
    const unsigned G = gridDim.x * gridDim.y * gridDim.z;
    unsigned sum, cnt, mine, sp = 0u;
    for (;;) {
        sum = 0u; cnt = 0u; mine = 0u;
#pragma unroll
        for (unsigned j = 0; j < 16; ++j) { const unsigned c = xb_ld(&bar[XB_XCNT(j)]); sum += c; cnt += (c > 0u) ? 1u : 0u; mine = (j == x) ? c : mine; }
        if (sum == G) break;
        __builtin_amdgcn_s_sleep(1);
        if ((++sp & 255u) == 0u) { if (xb_ld(&bar[XB_TMO])) break; if (sp > XB_SPIN_CAP) { atomicAdd(&bar[XB_TMO], 1u); break; } }
    }
    nloc = mine > 0u ? mine : 1u; nx = cnt > 0u ? cnt : 1u;
}

__device__ __forceinline__ void xcd_barrier(const XcdBarrier& b) {
    asm volatile("s_waitcnt vmcnt(0)" ::: "memory");
    __syncthreads();
    if (threadIdx.x == 0) {
        unsigned* bar = b.bar;
        __builtin_amdgcn_s_waitcnt(0);
        unsigned nloc = b.st[0], nx = b.st[1];
        if (nloc == 0u) { xcd_barrier_complete(bar, b.x, nloc, nx); b.st[0] = nloc; b.st[1] = nx; }
        const unsigned old = xb_add(&bar[XB_XSUB(b.x)], 1u);
        const unsigned gen = old / nloc;
        if (old + 1u == (gen + 1u) * nloc) {
            __builtin_amdgcn_fence(__ATOMIC_RELEASE, "agent");
            asm volatile("s_waitcnt vmcnt(0)" ::: "memory");
            const unsigned og = xb_add(&bar[XB_TOP], 1u);
            const unsigned tg = og / nx;
            if (og + 1u == (tg + 1u) * nx) xb_add(&bar[XB_TOPGEN], 1u);
            else XB_SPIN(xb_ld(&bar[XB_TOPGEN]) == tg, bar);
            __builtin_amdgcn_fence(__ATOMIC_ACQUIRE, "agent");
            xb_add(&bar[XB_XGEN(b.x)], 1u);
            asm volatile("s_waitcnt vmcnt(0)" ::: "memory");
        } else {
            XB_SPIN(xb_ld(&bar[XB_XGEN(b.x)]) == gen, bar);
            __builtin_amdgcn_fence(__ATOMIC_ACQUIRE, "agent");
            asm volatile("s_waitcnt vmcnt(0)" ::: "memory");
        }
    }
    __syncthreads();
}


struct Args { const float* in[22]; float* out; unsigned char* ws; int ph_lo, ph_hi; };

__device__ __forceinline__ void prep_weights(const Args& a, int l, LAS unsigned char* lds, int tid, int lane, int wave) {
    unsigned char* wsw = a.ws + WS_W;
    LAS float* scr = (LAS float*)(lds + wave * 16384);
    const int gw = blockIdx.x * NWAVES + wave, NGW = gridDim.x * NWAVES;
    constexpr int I_IN = (D / 64) * (DIN / 32), I_UP = (D / 64) * (DFF2 / 32), I_DN = (DFF / 64) * (D / 32), I_OUT = (D / 64) * (D / 32), I_P = (WID / 64) * (D / 32), I_PW = (256 / 64) * (256 / 32);
    constexpr int NITEMS = I_IN + I_UP + I_DN + I_OUT + 3 * I_P + 4 * I_PW;
    for (int it = gw; it < NITEMS; it += NGW) {
        int r = it;
        if (r < I_IN) { transpose_item(a.in[1] + (size_t)l * D * DIN, D, DIN, (bf16*)(wsw + W_IN), scr, r, lane); continue; } r -= I_IN;
        if (r < I_UP) { transpose_item(a.in[16] + (size_t)l * D * DFF2, D, DFF2, (bf16*)(wsw + W_UP), scr, r, lane); continue; } r -= I_UP;
        if (r < I_DN) { transpose_item(a.in[19] + (size_t)l * DFF * D, DFF, D, (bf16*)(wsw + W_DOWN), scr, r, lane); continue; } r -= I_DN;
        if (r < I_OUT) { transpose_item(a.in[13] + (size_t)l * D * D, D, D, (bf16*)(wsw + W_OUT), scr, r, lane); continue; } r -= I_OUT;
        if (r < 3 * I_P) { const int br = r / I_P; transpose_item((br == 0 ? a.in[10] : (br == 1 ? a.in[11] : a.in[12])) + (size_t)l * WID * D, WID, D, (bf16*)(wsw + W_P) + (size_t)br * D * WID, scr, r % I_P, lane); continue; } r -= 3 * I_P;
        { const int g = r / I_PW; transpose_item(a.in[4] + ((size_t)l * 4 + g) * 65536, 256, 256, (bf16*)(wsw + W_PW) + (size_t)g * 65536, scr, r % I_PW, lane); }
    }
    const float* sw = a.in[8] + (size_t)l * 8 * 128 * 128; bf16* so = (bf16*)(wsw + W_SGW);
    for (int e = blockIdx.x * NT + tid; e < 8 * 128 * 128; e += gridDim.x * NT) { const int s = e & 127, t = (e >> 7) & 127; so[e] = (bf16)f2bf(s <= t ? sw[e] : 0.f); }
}

__device__ __forceinline__ void ln_rows(const float* T, const float* g, const float* b, float* outF, bf16* outB, int lane, int wave) {
    const int gw = blockIdx.x * NWAVES + wave, NGW = gridDim.x * NWAVES;
    for (int row = gw; row < M; row += NGW) {
        const f32x4* tr = (const f32x4*)(T + (size_t)row * D) + lane;
        f32x4 v[8]; float s = 0.f;
#pragma unroll
        for (int j = 0; j < 8; ++j) { v[j] = tr[64 * j]; s += (v[j][0] + v[j][1]) + (v[j][2] + v[j][3]); }
        const float mean = wave_sum(s) * (1.f / D); float s2 = 0.f;
#pragma unroll
        for (int j = 0; j < 8; ++j) { v[j] = v[j] - mean; s2 += (v[j][0] * v[j][0] + v[j][1] * v[j][1]) + (v[j][2] * v[j][2] + v[j][3] * v[j][3]); }
        const float rstd = 1.0f / sqrtf(wave_sum(s2) * (1.f / D) + LN_EPS);
#pragma unroll
        for (int j = 0; j < 8; ++j) {
            const f32x4 gg = ((const f32x4*)g)[64 * j + lane], bb = ((const f32x4*)b)[64 * j + lane];
            const f32x4 y = v[j] * rstd * gg + bb;
            if (outF) ((f32x4*)(outF + (size_t)row * D))[64 * j + lane] = y;
            if (outB) { u32x2 w; w.x = pk2(y[0], y[1]); w.y = pk2(y[2], y[3]); ((u32x2*)(outB + (size_t)row * D))[64 * j + lane] = w; }
        }
    }
}

__device__ __forceinline__ void sgu_stats(const bf16* Z, float* STAT, int lane, int wave) {
    const int gw = blockIdx.x * NWAVES + wave, NGW = gridDim.x * NWAVES;
    for (int row = gw; row < M; row += NGW) {
        const u32x4* p = (const u32x4*)(Z + (size_t)row * DIN + ZSV) + lane;
        const u32x4 a = p[0], c = p[64];
        float v[16] = {blo(a.x), bhi(a.x), blo(a.y), bhi(a.y), blo(a.z), bhi(a.z), blo(a.w), bhi(a.w), blo(c.x), bhi(c.x), blo(c.y), bhi(c.y), blo(c.z), bhi(c.z), blo(c.w), bhi(c.w)};
        float s = 0.f;
#pragma unroll
        for (int j = 0; j < 16; ++j) s += v[j];
        const float mean = wave_sum(s) * (1.f / 1024.f); float s2 = 0.f;
#pragma unroll
        for (int j = 0; j < 16; ++j) { const float d = v[j] - mean; s2 += d * d; }
        const float rstd = 1.0f / sqrtf(wave_sum(s2) * (1.f / 1024.f) + LN_EPS);
        if (lane == 0) { STAT[2 * row] = mean; STAT[2 * row + 1] = rstd; }
    }
}

__device__ __forceinline__ void hg_pass1(int item, LAS unsigned char* lds, const bf16* Z, const float* LF, float* UT, float* DEC, int tid, int lane, int wave) {
    const int bh = item >> 5, c = item & 31, b = bh >> 3, h = bh & 7, row0 = b * SEQ + c * 64;
    LAS bf16* KT = (LAS bf16*)lds;
    LAS bf16* VT = KT + 128 * 72;
    LAS float* tot = (LAS float*)(VT + 128 * 72);
    const int k = tid & 127, part = tid >> 7, s0 = part * 16;
    float lf[16]; unsigned kv[16], vv[16];
#pragma unroll
    for (int i = 0; i < 16; ++i) { const size_t row = (size_t)(row0 + s0 + i);
        lf[i] = LF[row * 1024 + h * 128 + k]; kv[i] = Z[row * DIN + ZK + h * 128 + k]; vv[i] = Z[row * DIN + ZV + h * 128 + k]; }
#pragma unroll
    for (int i = 1; i < 16; ++i) lf[i] += lf[i - 1];
    tot[part * 128 + k] = lf[15];
    __syncthreads();
    const float t0 = tot[k], t1 = tot[128 + k], t2 = tot[256 + k], t3 = tot[384 + k];
    const float prefix = (part > 0 ? t0 : 0.f) + (part > 1 ? t1 : 0.f) + (part > 2 ? t2 : 0.f);
    const float blast = ((t0 + t1) + t2) + t3;
    unsigned kw[8], vw[8];
#pragma unroll
    for (int i = 0; i < 8; ++i) {
        const float e0 = __expf(blast - (prefix + lf[2 * i])), e1 = __expf(blast - (prefix + lf[2 * i + 1]));
        kw[i] = pk2(bf2f((bf16)kv[2 * i]) * e0, bf2f((bf16)kv[2 * i + 1]) * e1);
        vw[i] = vv[2 * i] | (vv[2 * i + 1] << 16);
    }
    *(LAS u32x4*)(KT + k * 72 + s0) = (u32x4){kw[0], kw[1], kw[2], kw[3]}; *(LAS u32x4*)(KT + k * 72 + s0 + 8) = (u32x4){kw[4], kw[5], kw[6], kw[7]};
    *(LAS u32x4*)(VT + k * 72 + s0) = (u32x4){vw[0], vw[1], vw[2], vw[3]}; *(LAS u32x4*)(VT + k * 72 + s0 + 8) = (u32x4){vw[4], vw[5], vw[6], vw[7]};
    if (part == 0) DEC[(size_t)item * 128 + k] = __expf(blast);
    __syncthreads();
    f32x4 acc[8];
#pragma unroll
    for (int i = 0; i < 8; ++i) acc[i] = (f32x4){0.f, 0.f, 0.f, 0.f};
#pragma unroll
    for (int ks = 0; ks < 2; ++ks) {
        const bf16x8 bf = lfrag(VT, 72, 16 * wave, 32 * ks, lane);
#pragma unroll
        for (int kt = 0; kt < 8; ++kt) acc[kt] = MMA(lfrag(KT, 72, 16 * kt, 32 * ks, lane), bf, acc[kt]);
    }
    float* up = UT + (size_t)item * 16384 + (size_t)(16 * wave + (lane & 15)) * 128 + 4 * (lane >> 4);
#pragma unroll
    for (int kt = 0; kt < 8; ++kt) *(f32x4*)(up + 16 * kt) = acc[kt];
    __syncthreads();
}

__device__ __forceinline__ void hg_scan(const float* UT, const float* DEC, bf16* ST, int tid) {
    for (int e = blockIdx.x * NT + tid; e < 32 * 4096; e += gridDim.x * NT) {
        const int bh = e >> 12, r = e & 4095, v = r >> 5, k4 = (r & 31) * 4;
        f32x4 S = {0.f, 0.f, 0.f, 0.f};
#pragma unroll 4
        for (int c = 0; c < 32; ++c) {
            const size_t item = (size_t)bh * 32 + c;
            u32x2 w; w.x = pk2(S[0], S[1]); w.y = pk2(S[2], S[3]);
            *(u32x2*)(ST + item * 16384 + v * 128 + k4) = w;
            const f32x4 d = *(const f32x4*)(DEC + item * 128 + k4), u = *(const f32x4*)(UT + item * 16384 + v * 128 + k4);
            S = d * S + u;
        }
    }
}

__device__ __forceinline__ void hg_pass3(int item, LAS unsigned char* lds, const bf16* Z, const float* LF, const bf16* ST, const float* norm_g, bf16* Y, int tid, int lane, int wave) {
    const int bh = item >> 5, c = item & 31, b = bh >> 3, h = bh & 7, row0 = b * SEQ + c * 64;
    LAS bf16* Qpp = (LAS bf16*)lds;
    LAS bf16* Qp = Qpp + 64 * 136;
    LAS bf16* Kp = Qp + 64 * 136;
    LAS bf16* VT = Kp + 64 * 136;
    LAS bf16* P = VT + 128 * 72;
    LAS float* tot = (LAS float*)(P + 64 * 72);
    LAS float* ssq = tot + 512;
    const int k = tid & 127, part = tid >> 7, s0 = part * 16;
    {
        float lf[16]; unsigned qv[16], kv[16], vv[16];
#pragma unroll
        for (int i = 0; i < 16; ++i) { const size_t row = (size_t)(row0 + s0 + i);
            lf[i] = LF[row * 1024 + h * 128 + k]; qv[i] = Z[row * DIN + ZQ + h * 128 + k]; kv[i] = Z[row * DIN + ZK + h * 128 + k]; vv[i] = Z[row * DIN + ZV + h * 128 + k]; }
#pragma unroll
        for (int i = 1; i < 16; ++i) lf[i] += lf[i - 1];
        tot[part * 128 + k] = lf[15];
        __syncthreads();
        const float t0 = tot[k], t1 = tot[128 + k], t2 = tot[256 + k];
        const float prefix = (part > 0 ? t0 : 0.f) + (part > 1 ? t1 : 0.f) + (part > 2 ? t2 : 0.f);
        const float bmid = t0 + t1;
        unsigned vw[8];
#pragma unroll
        for (int i = 0; i < 16; ++i) {
            const float bb = prefix + lf[i], q = bf2f((bf16)qv[i]), kk = bf2f((bf16)kv[i]);
            const int s = s0 + i;
            Qpp[s * 136 + k] = (bf16)f2bf(q * __expf(bb));
            Qp[s * 136 + k] = (bf16)f2bf(q * __expf(bb - bmid));
            Kp[s * 136 + k] = (bf16)f2bf(kk * __expf(bmid - bb));
        }
#pragma unroll
        for (int i = 0; i < 8; ++i) vw[i] = vv[2 * i] | (vv[2 * i + 1] << 16);
        *(LAS u32x4*)(VT + k * 72 + s0) = (u32x4){vw[0], vw[1], vw[2], vw[3]}; *(LAS u32x4*)(VT + k * 72 + s0 + 8) = (u32x4){vw[4], vw[5], vw[6], vw[7]};
    }
    __syncthreads();
    const int fr = lane & 15, fq = lane >> 4;
    {
        const int ti = wave >> 1;
#pragma unroll
        for (int x = 0; x < 2; ++x) {
            const int si = 2 * (wave & 1) + x;
            f32x4 acc = {0.f, 0.f, 0.f, 0.f};
            if (si <= ti) {
#pragma unroll
                for (int ks = 0; ks < 4; ++ks) acc = MMA(lfrag(Kp, 136, 16 * si, 32 * ks, lane), lfrag(Qp, 136, 16 * ti, 32 * ks, lane), acc);
            }
            const int t = 16 * ti + fr, sb = 16 * si + 4 * fq;
            float p0 = (sb + 0 <= t) ? acc[0] : 0.f, p1 = (sb + 1 <= t) ? acc[1] : 0.f, p2 = (sb + 2 <= t) ? acc[2] : 0.f, p3 = (sb + 3 <= t) ? acc[3] : 0.f;
            u32x2 w; w.x = pk2(p0, p1); w.y = pk2(p2, p3);
            *(LAS u32x2*)(P + t * 72 + sb) = w;
        }
    }
    __syncthreads();
    const int ti = wave & 3, vt0 = 4 * (wave >> 2);
    f32x4 acc[4];
#pragma unroll
    for (int n = 0; n < 4; ++n) acc[n] = (f32x4){0.f, 0.f, 0.f, 0.f};
    const bf16* Sg = ST + (size_t)item * 16384;
#pragma unroll
    for (int ks = 0; ks < 4; ++ks) {
        const bf16x8 bf = lfrag(Qpp, 136, 16 * ti, 32 * ks, lane);
#pragma unroll
        for (int n = 0; n < 4; ++n) acc[n] = MMA(gfrag(Sg, 128, 16 * (vt0 + n), 32 * ks, lane), bf, acc[n]);
    }
#pragma unroll
    for (int ks = 0; ks < 2; ++ks) {
        const bf16x8 bf = lfrag(P, 72, 16 * ti, 32 * ks, lane);
#pragma unroll
        for (int n = 0; n < 4; ++n) acc[n] = MMA(lfrag(VT, 72, 16 * (vt0 + n), 32 * ks, lane), bf, acc[n]);
    }
    float ss = 0.f;
#pragma unroll
    for (int n = 0; n < 4; ++n) ss += (acc[n][0] * acc[n][0] + acc[n][1] * acc[n][1]) + (acc[n][2] * acc[n][2] + acc[n][3] * acc[n][3]);
    ss += __shfl_xor(ss, 16); ss += __shfl_xor(ss, 32);
    const int t = 16 * ti + fr;
    if (fq == 0) ssq[(wave >> 2) * 64 + t] = ss;
    __syncthreads();
    const float rinv = 1.0f / sqrtf((ssq[t] + ssq[64 + t]) * (1.f / 128.f) + RMS_EPS);
    const size_t row = (size_t)(row0 + t);
#pragma unroll
    for (int n = 0; n < 4; ++n) {
        const int col = h * 128 + 16 * (vt0 + n) + 4 * fq;
        const f32x4 g = *(const f32x4*)(norm_g + col);
        const u32x2 ow = *(const u32x2*)(Z + row * DIN + ZOG + col);
        const f32x4 y = {acc[n][0] * rinv * g[0] * blo(ow.x), acc[n][1] * rinv * g[1] * bhi(ow.x), acc[n][2] * rinv * g[2] * blo(ow.y), acc[n][3] * rinv * g[3] * bhi(ow.y)};
        u32x2 w; w.x = pk2(y[0], y[1]); w.y = pk2(y[2], y[3]);
        *(u32x2*)(Y + row * WID + col) = w;
    }
    __syncthreads();
}

__device__ __forceinline__ void pool_item(int item, LAS unsigned char* lds, const bf16* Z, const bf16* PWT, const float* scale, bf16* Y, int tid, int lane, int wave) {
    const int g = item & 3, tile = item >> 2, row0 = tile * 128, tseq0 = row0 & (SEQ - 1);
    const int w = 2 << g;
    LAS bf16* A = (LAS bf16*)lds;
    {
        const int cg8 = (tid & 31) * 8, run = tid >> 5;
        const bf16* zp = Z + ZP + g * 256 + cg8;
        float sum[8];
#pragma unroll
        for (int j = 0; j < 8; ++j) sum[j] = 0.f;
        const int ts0 = tseq0 + run * 8;
        for (int i = w - 1; i >= 1; --i) {
            if (ts0 - i >= 0) { const u32x4 p = *(const u32x4*)(zp + (size_t)(row0 + run * 8 - i) * DIN);
                sum[0] += blo(p.x); sum[1] += bhi(p.x); sum[2] += blo(p.y); sum[3] += bhi(p.y); sum[4] += blo(p.z); sum[5] += bhi(p.z); sum[6] += blo(p.w); sum[7] += bhi(p.w); }
        }
#pragma unroll
        for (int j = 0; j < 8; ++j) {
            const int tl = run * 8 + j, ts = tseq0 + tl;
            const u32x4 p = *(const u32x4*)(zp + (size_t)(row0 + tl) * DIN);
            const float cur[8] = {blo(p.x), bhi(p.x), blo(p.y), bhi(p.y), blo(p.z), bhi(p.z), blo(p.w), bhi(p.w)};
            const float inv = 1.0f / (float)((ts + 1) < w ? (ts + 1) : w);
            float o[8];
#pragma unroll
            for (int q = 0; q < 8; ++q) { sum[q] += cur[q]; o[q] = sum[q] * inv - cur[q]; }
            *(LAS u32x4*)(A + tl * 264 + cg8) = (u32x4){pk2(o[0], o[1]), pk2(o[2], o[3]), pk2(o[4], o[5]), pk2(o[6], o[7])};
            if (ts - w + 1 >= 0) { const u32x4 r = *(const u32x4*)(zp + (size_t)(row0 + tl - w + 1) * DIN);
                sum[0] -= blo(r.x); sum[1] -= bhi(r.x); sum[2] -= blo(r.y); sum[3] -= bhi(r.y); sum[4] -= blo(r.z); sum[5] -= bhi(r.z); sum[6] -= blo(r.w); sum[7] -= bhi(r.w); }
        }
    }
    __syncthreads();
    f32x4 acc[2][8];
#pragma unroll
    for (int n = 0; n < 2; ++n)
#pragma unroll
        for (int m = 0; m < 8; ++m) acc[n][m] = (f32x4){0.f, 0.f, 0.f, 0.f};
    const bf16* Wg = PWT + (size_t)g * 65536;
#pragma unroll 2
    for (int ks = 0; ks < 8; ++ks) {
        const bf16x8 a0 = gfrag(Wg, 256, 32 * wave, 32 * ks, lane), a1 = gfrag(Wg, 256, 32 * wave + 16, 32 * ks, lane);
#pragma unroll
        for (int m = 0; m < 8; ++m) { const bf16x8 bf = lfrag(A, 264, 16 * m, 32 * ks, lane); acc[0][m] = MMA(a0, bf, acc[0][m]); acc[1][m] = MMA(a1, bf, acc[1][m]); }
    }
    const int fr = lane & 15, fq = lane >> 4;
#pragma unroll
    for (int n = 0; n < 2; ++n) {
        const int col = g * 256 + 32 * wave + 16 * n + 4 * fq;
        const f32x4 sc = *(const f32x4*)(scale + col);
#pragma unroll
        for (int m = 0; m < 8; ++m) {
            const f32x4 y = acc[n][m] * sc;
            u32x2 wv; wv.x = pk2(y[0], y[1]); wv.y = pk2(y[2], y[3]);
            *(u32x2*)(Y + (size_t)(row0 + 16 * m + fr) * WID + col) = wv;
        }
    }
    __syncthreads();
}

__device__ __forceinline__ void sgu_item(int item, LAS unsigned char* lds, const bf16* Z, const float* STAT, const bf16* SGW, const float* ln_g, const float* ln_b, const float* sg_b, bf16* Y, int tid, int lane, int wave) {
    const int g = item & 7, chunk = item >> 3, row0 = chunk * 128;
    LAS bf16* VT = (LAS bf16*)lds;
    {
        const int d = tid & 127, part = tid >> 7;
        const float gg = ln_g[g * 128 + d], bb = ln_b[g * 128 + d];
        unsigned wv[16];
#pragma unroll
        for (int i = 0; i < 16; ++i) {
            const int s = part * 32 + 2 * i;
            const float v0 = bf2f(Z[(size_t)(row0 + s) * DIN + ZSV + g * 128 + d]), v1 = bf2f(Z[(size_t)(row0 + s + 1) * DIN + ZSV + g * 128 + d]);
            const float m0 = STAT[2 * (row0 + s)], r0 = STAT[2 * (row0 + s) + 1], m1 = STAT[2 * (row0 + s + 1)], r1 = STAT[2 * (row0 + s + 1) + 1];
            wv[i] = pk2((v0 - m0) * r0 * gg + bb, (v1 - m1) * r1 * gg + bb);
        }
#pragma unroll
        for (int i = 0; i < 4; ++i) *(LAS u32x4*)(VT + d * 136 + part * 32 + 8 * i) = (u32x4){wv[4 * i], wv[4 * i + 1], wv[4 * i + 2], wv[4 * i + 3]};
    }
    __syncthreads();
    f32x4 acc[8];
#pragma unroll
    for (int n = 0; n < 8; ++n) acc[n] = (f32x4){0.f, 0.f, 0.f, 0.f};
    const bf16* Wg = SGW + (size_t)g * 16384;
#pragma unroll
    for (int ks = 0; ks < 4; ++ks) {
        const bf16x8 bf = gfrag(Wg, 128, 16 * wave, 32 * ks, lane);
#pragma unroll
        for (int n = 0; n < 8; ++n) acc[n] = MMA(lfrag(VT, 136, 16 * n, 32 * ks, lane), bf, acc[n]);
    }
    const int fr = lane & 15, fq = lane >> 4, t = 16 * wave + fr;
    const float bs = sg_b[g * 128 + t];
    const size_t row = (size_t)(row0 + t);
#pragma unroll
    for (int n = 0; n < 8; ++n) {
        const int col = g * 128 + 16 * n + 4 * fq;
        const u32x2 uw = *(const u32x2*)(Z + row * DIN + ZU + col);
        const f32x4 y = {(acc[n][0] + bs) * blo(uw.x), (acc[n][1] + bs) * bhi(uw.x), (acc[n][2] + bs) * blo(uw.y), (acc[n][3] + bs) * bhi(uw.y)};
        u32x2 wv; wv.x = pk2(y[0], y[1]); wv.y = pk2(y[2], y[3]);
        *(u32x2*)(Y + row * WID + col) = wv;
    }
    __syncthreads();
}

__device__ __forceinline__ void conv_gate(const bf16* H, const float* cw, const float* cb, bf16* G, int tid) {
    constexpr int NCG = DFF / 8, RUN = 16, NRUN = M / RUN;
    for (int e = blockIdx.x * NT + tid; e < NCG * NRUN; e += gridDim.x * NT) {
        const int cgi = e % NCG, run = e / NCG, j0 = cgi * 8, r0 = run * RUN, ts0 = r0 & (SEQ - 1);
        float wa[3][8], wb[3][8], ba[8], bb[8];
#pragma unroll
        for (int q = 0; q < 8; ++q) {
#pragma unroll
            for (int i = 0; i < 3; ++i) { wa[i][q] = cw[i * DFF2 + j0 + q]; wb[i][q] = cw[i * DFF2 + DFF + j0 + q]; }
            ba[q] = cb[j0 + q]; bb[q] = cb[DFF + j0 + q];
        }
        float a2[8], a1[8], b2[8], b1[8];
#pragma unroll
        for (int q = 0; q < 8; ++q) { a2[q] = a1[q] = b2[q] = b1[q] = 0.f; }
        if (ts0 >= 2) {
            const u32x4 pa2 = *(const u32x4*)(H + (size_t)(r0 - 2) * DFF2 + j0), pa1 = *(const u32x4*)(H + (size_t)(r0 - 1) * DFF2 + j0);
            const u32x4 pb2 = *(const u32x4*)(H + (size_t)(r0 - 2) * DFF2 + DFF + j0), pb1 = *(const u32x4*)(H + (size_t)(r0 - 1) * DFF2 + DFF + j0);
            a2[0] = blo(pa2.x); a2[1] = bhi(pa2.x); a2[2] = blo(pa2.y); a2[3] = bhi(pa2.y); a2[4] = blo(pa2.z); a2[5] = bhi(pa2.z); a2[6] = blo(pa2.w); a2[7] = bhi(pa2.w);
            a1[0] = blo(pa1.x); a1[1] = bhi(pa1.x); a1[2] = blo(pa1.y); a1[3] = bhi(pa1.y); a1[4] = blo(pa1.z); a1[5] = bhi(pa1.z); a1[6] = blo(pa1.w); a1[7] = bhi(pa1.w);
            b2[0] = blo(pb2.x); b2[1] = bhi(pb2.x); b2[2] = blo(pb2.y); b2[3] = bhi(pb2.y); b2[4] = blo(pb2.z); b2[5] = bhi(pb2.z); b2[6] = blo(pb2.w); b2[7] = bhi(pb2.w);
            b1[0] = blo(pb1.x); b1[1] = bhi(pb1.x); b1[2] = blo(pb1.y); b1[3] = bhi(pb1.y); b1[4] = blo(pb1.z); b1[5] = bhi(pb1.z); b1[6] = blo(pb1.w); b1[7] = bhi(pb1.w);
        }
#pragma unroll 4
        for (int i = 0; i < RUN; ++i) {
            const size_t row = (size_t)(r0 + i);
            const u32x4 pa = *(const u32x4*)(H + row * DFF2 + j0), pb = *(const u32x4*)(H + row * DFF2 + DFF + j0);
            const float a0[8] = {blo(pa.x), bhi(pa.x), blo(pa.y), bhi(pa.y), blo(pa.z), bhi(pa.z), blo(pa.w), bhi(pa.w)};
            const float b0[8] = {blo(pb.x), bhi(pb.x), blo(pb.y), bhi(pb.y), blo(pb.z), bhi(pb.z), blo(pb.w), bhi(pb.w)};
            float o[8];
#pragma unroll
            for (int q = 0; q < 8; ++q) {
                const float ca = ba[q] + wa[0][q] * a2[q] + wa[1][q] * a1[q] + wa[2][q] * a0[q];
                const float cbv = bb[q] + wb[0][q] * b2[q] + wb[1][q] * b1[q] + wb[2][q] * b0[q];
                o[q] = ca * pg8::sigm(ca) * cbv;
                a2[q] = a1[q]; a1[q] = a0[q]; b2[q] = b1[q]; b1[q] = b0[q];
            }
            *(u32x4*)(G + row * DFF + j0) = (u32x4){pk2(o[0], o[1]), pk2(o[2], o[3]), pk2(o[4], o[5]), pk2(o[6], o[7])};
        }
    }
}

__global__ void __launch_bounds__(NT, 2) fwd_kernel(Args a) {
    extern __shared__ __attribute__((aligned(16))) unsigned char lds_raw[];
    LAS unsigned char* lds = (LAS unsigned char*)lds_raw;
    cg::grid_group grid = cg::this_grid();
    const int wave = __builtin_amdgcn_readfirstlane(threadIdx.x >> 6);
    const int lo = a.ph_lo, hi = a.ph_hi, G = gridDim.x, bx = blockIdx.x;
    unsigned char* ws = a.ws;
    float* LB = (float*)(ws + WS_LB); float* STAT = (float*)(ws + WS_STAT); float* DEC = (float*)(ws + WS_DEC);
    bf16* WinT = (bf16*)(ws + WS_W + W_IN); bf16* WupT = (bf16*)(ws + WS_W + W_UP); bf16* WdownT = (bf16*)(ws + WS_W + W_DOWN); bf16* WoutT = (bf16*)(ws + WS_W + W_OUT);
    bf16* PT = (bf16*)(ws + WS_W + W_P); bf16* PWT = (bf16*)(ws + WS_W + W_PW); bf16* SGW = (bf16*)(ws + WS_W + W_SGW);
    bf16* XB = (bf16*)(ws + WS_XB); bf16* Z = (bf16*)(ws + WS_Z); bf16* H = Z;
    float* LF = (float*)(ws + WS_MIX + MIX_LF); float* UT = (float*)(ws + WS_MIX + MIX_UT); bf16* ST = (bf16*)(ws + WS_MIX + MIX_ST);
    bf16* GB = (bf16*)(ws + WS_MIX + MIX_G); float* TMP = (float*)(ws + WS_MIX + MIX_TMP);
    bf16* Yhg = (bf16*)(ws + WS_Y); bf16* Ypool = Yhg + (size_t)M * WID; bf16* Ysg = Ypool + (size_t)M * WID;
    bf16* MG = (bf16*)(ws + WS_MG); float* T = (float*)(ws + WS_T); float* X1F = (float*)(ws + WS_X1F); bf16* X1B = (bf16*)(ws + WS_X1B);

    volatile LAS unsigned* MISC = (volatile LAS unsigned*)(lds + 131072);
    if (threadIdx.x < 64) MISC[threadIdx.x] = 0u;
    unsigned* barw = (unsigned*)(ws + WS_BAR);
    if (lo == 0 && bx == 0) { for (int u = threadIdx.x; u < XCD_BAR_WORDS; u += NT) __hip_atomic_store(barw + u, 0u, __ATOMIC_RELAXED, __HIP_MEMORY_SCOPE_AGENT); }
    __syncthreads();
    XcdBarrier xbar; xbar.bar = barw; xbar.x = 0; xbar.st = MISC + 8;
    int ph = 0;
#define OPQ int tid_q = threadIdx.x; asm volatile("" : "+v"(tid_q)); const int tid = tid_q, lane = tid & 63; (void)lane;
#ifndef REP_MASK
#define REP_MASK 0
#endif
#define PH_ON (ph >= lo && ph < hi) for (int rep_ = 0, nrep_ = 1 + ((REP_MASK >> (ph % 12)) & 1); rep_ < nrep_; ++rep_)
#ifndef SYNC_REP
#define SYNC_REP 1
#endif
#define PH_NEXT do { ++ph; if (ph > lo && ph < hi) { for (int sr_ = 0; sr_ < SYNC_REP; ++sr_) { \
        if (ph == lo + 1 && sr_ == 0) { grid.sync(); xbar = xcd_barrier_post(barw, MISC + 8); }     \
        else xcd_barrier(xbar); } } } while (0)

    for (int l = 0; l < DEPTH; ++l) {
        const float* XF = (l == 0) ? a.in[0] : a.out;
        if PH_ON { OPQ
            prep_weights(a, l, lds, tid, lane, wave);
            if (l == 0) {
                const f32x4* x4 = (const f32x4*)a.in[0]; u32x2* xb2 = (u32x2*)XB;
                for (int e = bx * NT + tid; e < M * D / 4; e += G * NT) { const f32x4 v = x4[e]; u32x2 w; w.x = pk2(v[0], v[1]); w.y = pk2(v[2], v[3]); xb2[e] = w; }
                for (int e = bx * NT + tid; e < 1024; e += G * NT) { const float a0 = a.in[2][e], a1 = a.in[2][1024 + e]; LB[e] = 0.f; LB[1024 + e] = 1.0f / (1.0f + expf(a0 - a1)); }
            }
        }
        PH_NEXT;
        if PH_ON { OPQ
            pg8::Gemm g{XB, WinT, M, DIN, D}; pg8::StaticOrder S; S.init(M, DIN, G, bx);
            pg8::EpiIn E{Z, LF, LB + l * 1024};
            pg8::gemm_phase<pg8::EpiIn, pg8::StaticOrder, true, true>(lds, g, S, E);
        }
        PH_NEXT;
        if PH_ON { OPQ
            for (int it = bx; it < 1024 + 256; it += G) {
                if (it < 1024) hg_pass1(it, lds, Z, LF, UT, DEC, tid, lane, wave);
                else pool_item(it - 1024, lds, Z, PWT, a.in[5] + l * WID, Ypool, tid, lane, wave);
            }
            sgu_stats(Z, STAT, lane, wave);
        }
        PH_NEXT;
        if PH_ON { OPQ
            hg_scan(UT, DEC, ST, tid);
            for (int it = bx; it < 512; it += G) sgu_item(it, lds, Z, STAT, SGW, a.in[6] + l * WID, a.in[7] + l * WID, a.in[9] + l * 1024, Ysg, tid, lane, wave);
        }
        PH_NEXT;
        if PH_ON { OPQ
            for (int it = bx; it < 1024; it += G) hg_pass3(it, lds, Z, LF, ST, a.in[3] + l * WID, Yhg, tid, lane, wave);
        }
        PH_NEXT;
        if PH_ON { OPQ
            pg8::StaticOrder S; S.init(M, D, G, bx);
            { pg8::Gemm g{Yhg, PT, M, D, WID}; pg8::EpiGate<0> E{Z + ZG, TMP, MG}; pg8::gemm_phase<pg8::EpiGate<0>, pg8::StaticOrder, false, true>(lds, g, S, E); }
            { pg8::Gemm g{Ypool, PT + (size_t)D * WID, M, D, WID}; pg8::EpiGate<1> E{Z + ZG + D, TMP, MG}; pg8::gemm_phase<pg8::EpiGate<1>, pg8::StaticOrder, false, true>(lds, g, S, E); }
            { pg8::Gemm g{Ysg, PT + (size_t)2 * D * WID, M, D, WID}; pg8::EpiGate<2> E{Z + ZG + 2 * D, TMP, MG}; pg8::gemm_phase<pg8::EpiGate<2>, pg8::StaticOrder, false, true>(lds, g, S, E); }
        }
        PH_NEXT;
        if PH_ON { OPQ
            pg8::Gemm g{MG, WoutT, M, D, D}; pg8::StaticOrder S; S.init(M, D, G, bx);
            pg8::EpiRes E{XF, T, DN_ALPHA};
            pg8::gemm_phase<pg8::EpiRes, pg8::StaticOrder, false, true>(lds, g, S, E);
        }
        PH_NEXT;
        if PH_ON { OPQ ln_rows(T, a.in[14] + l * D, a.in[15] + l * D, X1F, X1B, lane, wave); }
        PH_NEXT;
        if PH_ON { OPQ
            pg8::Gemm g{X1B, WupT, M, DFF2, D}; pg8::StaticOrder S; S.init(M, DFF2, G, bx);
            pg8::EpiStore E{H, DFF2};
            pg8::gemm_phase<pg8::EpiStore, pg8::StaticOrder, true, true>(lds, g, S, E);
        }
        PH_NEXT;
        if PH_ON { OPQ conv_gate(H, a.in[17] + (size_t)l * 3 * DFF2, a.in[18] + (size_t)l * DFF2, GB, tid); }
        PH_NEXT;
        if PH_ON { OPQ
            pg8::Gemm g{GB, WdownT, M, D, DFF}; pg8::StaticOrder S; S.init(M, D, G, bx);
            pg8::EpiRes E{X1F, T, DN_ALPHA};
            pg8::gemm_phase<pg8::EpiRes, pg8::StaticOrder, false, true>(lds, g, S, E);
        }
        PH_NEXT;
        if PH_ON { OPQ
            ln_rows(T, a.in[20] + l * D, a.in[21] + l * D, a.out, (l + 1 < DEPTH) ? XB : nullptr, lane, wave);
        }
        PH_NEXT;
    }
#undef PH_ON
#undef PH_NEXT
}
constexpr int N_PHASES = DEPTH * 12;

#ifndef MK_MULTI
#define MK_MULTI 0
#endif
extern "C" void kernel_launch(void* const* d_in, const int* in_sizes, int n_in, void* d_out, int out_size, void* d_ws, size_t ws_size, hipStream_t stream) {
    static int grid = 0;
    if (grid == 0) {
        if (n_in != 22 || out_size != M * D || ws_size < WS_END) { fprintf(stderr, "kernel_launch: unexpected shapes (n_in %d, out %d, ws %zu)\n", n_in, out_size, ws_size); grid = -1; return; }
        int dev = 0, cus = 0, per_cu = 0;
        hipGetDevice(&dev); hipDeviceGetAttribute(&cus, hipDeviceAttributeMultiprocessorCount, dev);
        if (hipFuncSetAttribute((const void*)fwd_kernel, hipFuncAttributeMaxDynamicSharedMemorySize, LDS_BYTES) != hipSuccess) { fprintf(stderr, "kernel_launch: hipFuncSetAttribute failed\n"); grid = -1; return; }
        hipOccupancyMaxActiveBlocksPerMultiprocessor(&per_cu, (const void*)fwd_kernel, NT, LDS_BYTES);
        (void)hipGetLastError();
        if (per_cu < 1) per_cu = 1;
        grid = cus * 1;
        fprintf(stderr, "kernel_launch: cus %d per_cu %d grid %d\n", cus, per_cu, grid);
    }
    if (grid < 0) return;
    Args a{};
    for (int i = 0; i < 22; ++i) a.in[i] = (const float*)d_in[i];
    a.out = (float*)d_out; a.ws = (unsigned char*)d_ws;
#if MK_MULTI
    for (int p = 0; p < N_PHASES; ++p) { a.ph_lo = p; a.ph_hi = p + 1; hipLaunchKernelGGL(fwd_kernel, dim3(grid), dim3(NT), LDS_BYTES, stream, a); }
#else
    a.ph_lo = 0; a.ph_hi = N_PHASES;
    void* args[] = {&a};
    hipError_t e = hipLaunchCooperativeKernel((const void*)fwd_kernel, dim3(grid), dim3(NT), args, LDS_BYTES, stream);
    if (e != hipSuccess) fprintf(stderr, "cooperative launch failed: %s (grid %d)\n", hipGetErrorString(e), grid);
#endif
}
```
